# Optimizing an MI355X kernel written in HIP

```python
import math
import jax, jax.numpy as jnp
from jax import lax
import numpy as np

D_MODEL = 1024
BATCH = 16
SEQ = 2048
DEPTH = 4

CHUNK = 64
QBLOCK = 128
HEAD_DIM = 64
N_GROUPS = 4
GROUP_HEADS = D_MODEL // (N_GROUPS * HEAD_DIM)
GROUP_WIDTH = GROUP_HEADS * HEAD_DIM
D_MIX = N_GROUPS * GROUP_WIDTH
IDX_HEADS = 8
IDX_DIM = 32
TOPK_MAX = 256
T5_BUCKETS = 32
T5_MAX_DIST = 128
Q_LORA = 192
KV_LORA = 128
MLA_NOPE = HEAD_DIM
MLA_ROPE = HEAD_DIM // 2
MLA_V = HEAD_DIM
ROPE_THETA = 10000.0
LEFT_CHUNKS = 8
MAX_REL = 256
N_EXPERTS = 64
TOP_K = 8
D_EXPERT = D_MODEL // 4
D_SHARED = D_EXPERT
ROUTED_SCALE = 2.5
ALPHA = (2 * DEPTH) ** 0.25
BETA = (8 * DEPTH) ** -0.25
LN_EPS = 1e-5
RMS_EPS = 1e-6
IN_SIZES = (3 * GROUP_WIDTH, GROUP_HEADS, 3 * GROUP_WIDTH, IDX_HEADS * IDX_DIM, IDX_DIM, IDX_HEADS,
            Q_LORA, KV_LORA, MLA_ROPE, 3 * GROUP_WIDTH)
IN_SPLITS = tuple(int(v) for v in np.cumsum(IN_SIZES)[:-1])
D_IN = sum(IN_SIZES)

kernel_name = 'hybrid_fox_dsa_mla_chunkband_moe_deepnorm'


def _layer_norm(x, g, b):
    xf = x.astype(jnp.float32)
    mu = jnp.mean(xf, axis=-1, keepdims=True)
    var = jnp.mean(jnp.square(xf - mu), axis=-1, keepdims=True)
    y = (xf - mu) * lax.rsqrt(var + LN_EPS)
    return (y * g.astype(jnp.float32) + b.astype(jnp.float32)).astype(x.dtype)


def _rms_norm(x, g):
    xf = x.astype(jnp.float32)
    y = xf * lax.rsqrt(jnp.mean(jnp.square(xf), axis=-1, keepdims=True) + RMS_EPS)
    return (y * g.astype(jnp.float32)).astype(x.dtype)


def _rope(x, pos):
    half = x.shape[-1] // 2
    inv_freq = ROPE_THETA ** (-jnp.arange(half, dtype=jnp.float32) / half)
    ang = pos.astype(jnp.float32)[:, None] * inv_freq[None, :]
    shape = (1, x.shape[1]) + (1,) * (x.ndim - 3) + (half,)
    cos = jnp.cos(ang).reshape(shape)
    sin = jnp.sin(ang).reshape(shape)
    x1 = x[..., :half].astype(jnp.float32)
    x2 = x[..., half:].astype(jnp.float32)
    return jnp.concatenate([x1 * cos - x2 * sin, x2 * cos + x1 * sin], axis=-1).astype(x.dtype)


def _t5_bucket(rel):
    half = T5_BUCKETS // 2
    max_exact = half // 2
    n = jnp.abs(rel)
    large = max_exact + (jnp.log(jnp.maximum(n, 1).astype(jnp.float32) / max_exact)
                         / math.log(T5_MAX_DIST / max_exact) * (half - max_exact)).astype(jnp.int32)
    large = jnp.minimum(large, half - 1)
    return jnp.where(rel > 0, half, 0) + jnp.where(n < max_exact, n, large)


def _query_block_attention(q, k, v, scale, block_bias):
    b, s, h, dk = q.shape
    dv = v.shape[-1]
    nb = s // QBLOCK
    q_blocks = jnp.moveaxis(q.reshape(b, nb, QBLOCK, h, dk), 1, 0)

    def one_block(args):
        i, q_i = args
        logits = jnp.einsum('bqhd,bshd->bhqs', q_i, k).astype(jnp.float32) * scale
        p = jax.nn.softmax(logits + block_bias(i), axis=-1).astype(v.dtype)
        return jnp.einsum('bhqs,bshd->bqhd', p, v)

    out = lax.map(one_block, (jnp.arange(nb), q_blocks))
    return jnp.moveaxis(out, 0, 1).reshape(b, s, h * dv)


def _fox_group(qkv, f_logit, b_f):
    b, s, _ = qkv.shape
    q, k, v = [t.reshape(b, s, GROUP_HEADS, HEAD_DIM) for t in jnp.split(qkv, 3, axis=-1)]
    log_f = jax.nn.log_sigmoid(f_logit.astype(jnp.float32) + b_f.astype(jnp.float32))
    cum = jnp.transpose(jnp.cumsum(log_f, axis=1), (0, 2, 1))
    s_pos = jnp.arange(s)

    def block_bias(i):
        t_pos = i * QBLOCK + jnp.arange(QBLOCK)
        cum_q = lax.dynamic_slice_in_dim(cum, i * QBLOCK, QBLOCK, axis=2)
        decay = cum_q[..., :, None] - cum[..., None, :]
        return jnp.where(s_pos[None, :] <= t_pos[:, None], decay, -jnp.inf)

    return _query_block_attention(q, k, v, HEAD_DIM ** -0.5, block_bias)


def _dsa_group(qkv, idx_q, idx_k, idx_w, t5_table):
    b, s, _ = qkv.shape
    nc = s // CHUNK
    n_sel = min(TOPK_MAX, s // 4)
    q, k, v = jnp.split(qkv, 3, axis=-1)
    q = q.reshape(b, s, GROUP_HEADS, HEAD_DIM)
    iq = idx_q.reshape(b, s, IDX_HEADS, IDX_DIM)
    iw = idx_w.astype(jnp.float32) * (IDX_HEADS ** -0.5 * IDX_DIM ** -0.5)
    s_pos = jnp.arange(s)
    gather_rows = jax.vmap(lambda rows, ids: rows[ids])

    def to_chunks(a):
        return jnp.moveaxis(a.reshape((b, nc, CHUNK) + a.shape[2:]), 1, 0)

    def one_chunk(args):
        c, q_c, iq_c, iw_c = args
        limit = (c + 1) * CHUNK
        dots = jnp.einsum('bqhd,bsd->bqhs', iq_c, idx_k).astype(jnp.float32)
        score = jnp.einsum('bqhs,bqh->bqs', jax.nn.relu(dots), iw_c)
        score = jnp.where(s_pos < limit, score, -jnp.inf)
        _, sel = lax.top_k(score, n_sel)
        k_sel = gather_rows(k, sel).reshape(b, CHUNK, n_sel, GROUP_HEADS, HEAD_DIM)
        v_sel = gather_rows(v, sel).reshape(b, CHUNK, n_sel, GROUP_HEADS, HEAD_DIM)
        logits = jnp.einsum('bqhd,bqkhd->bhqk', q_c, k_sel).astype(jnp.float32) * HEAD_DIM ** -0.5
        rel = sel - (c * CHUNK + jnp.arange(CHUNK))[None, :, None]
        pos_bias = jnp.moveaxis(t5_table[_t5_bucket(rel)], -1, 1).astype(jnp.float32)
        logits = jnp.where((sel < limit)[:, None], logits + pos_bias, -jnp.inf)
        p = jax.nn.softmax(logits, axis=-1).astype(v.dtype)
        return jnp.einsum('bhqk,bqkhd->bqhd', p, v_sel)

    out = lax.map(one_chunk, (jnp.arange(nc), to_chunks(q), to_chunks(iq), to_chunks(iw)))
    return jnp.moveaxis(out, 0, 1).reshape(b, s, GROUP_WIDTH)


def _mla_group(c_q, c_kv, k_r, q_norm, kv_norm, w_uq, w_ukv, pos):
    b, s, _ = c_q.shape
    q = (_rms_norm(c_q, q_norm) @ w_uq).reshape(b, s, GROUP_HEADS, MLA_NOPE + MLA_ROPE)
    q = jnp.concatenate([q[..., :MLA_NOPE], _rope(q[..., MLA_NOPE:], pos)], axis=-1)
    kv = (_rms_norm(c_kv, kv_norm) @ w_ukv).reshape(b, s, GROUP_HEADS, MLA_NOPE + MLA_V)
    k_rope = jnp.broadcast_to(_rope(k_r, pos)[:, :, None, :], (b, s, GROUP_HEADS, MLA_ROPE))
    k = jnp.concatenate([kv[..., :MLA_NOPE], k_rope], axis=-1)
    v = kv[..., MLA_NOPE:]
    key_chunk = jnp.arange(s) // CHUNK

    def block_bias(i):
        q_chunk = (i * QBLOCK + jnp.arange(QBLOCK)) // CHUNK
        return jnp.where(key_chunk[None, :] <= q_chunk[:, None], 0.0, -jnp.inf)

    return _query_block_attention(q, k, v, (MLA_NOPE + MLA_ROPE) ** -0.5, block_bias)


def _chunk_band_group(qkv, rel_table):
    b, s, _ = qkv.shape
    nc = s // CHUNK
    band = (LEFT_CHUNKS + 1) * CHUNK
    q, k, v = [t.reshape(b, nc, CHUNK, GROUP_HEADS, HEAD_DIM) for t in jnp.split(qkv, 3, axis=-1)]

    def key_band(a):
        a_pad = jnp.pad(a, ((0, 0), (LEFT_CHUNKS, 0), (0, 0), (0, 0), (0, 0)))
        return jnp.concatenate([a_pad[:, j:j + nc] for j in range(LEFT_CHUNKS + 1)], axis=2)

    k_band, v_band = key_band(k), key_band(v)
    logits = jnp.einsum('bcqhd,bckhd->bchqk', q, k_band).astype(jnp.float32) * HEAD_DIM ** -0.5
    r = jnp.arange(band)
    dist = jnp.arange(CHUNK)[:, None] + LEFT_CHUNKS * CHUNK - r[None, :]
    rel_bias = rel_table[:, jnp.clip(dist, -MAX_REL, MAX_REL) + MAX_REL].astype(jnp.float32)
    key_pos = jnp.arange(nc)[:, None] * CHUNK - LEFT_CHUNKS * CHUNK + r[None, :]
    valid = (key_pos >= 0)[None, :, None, None, :]
    logits = jnp.where(valid, logits + rel_bias[None, None], -jnp.inf)
    p = jax.nn.softmax(logits, axis=-1).astype(v.dtype)
    return jnp.einsum('bchqk,bckhd->bcqhd', p, v_band).reshape(b, s, GROUP_WIDTH)


def _moe(x, w_router, router_bias, w_gu, w_down, w_sh_gu, w_sh_down):
    b, s, d = x.shape
    xt = x.reshape(b * s, d)
    n = xt.shape[0]
    scores = jax.nn.sigmoid((xt @ w_router).astype(jnp.float32))
    _, sel = lax.top_k(scores + router_bias.astype(jnp.float32), TOP_K)
    s_sel = jnp.take_along_axis(scores, sel, axis=-1)
    g = s_sel / jnp.sum(s_sel, axis=-1, keepdims=True) * ROUTED_SCALE
    gates_t = jnp.zeros_like(scores).at[jnp.arange(n)[:, None], sel].set(g).T.astype(x.dtype)

    def add_expert(e, acc):
        h = xt @ w_gu[e]
        a = jax.nn.silu(h[:, :D_EXPERT]) * h[:, D_EXPERT:]
        return acc + (a * gates_t[e][:, None]) @ w_down[e]

    routed = lax.fori_loop(0, N_EXPERTS, add_expert, jnp.zeros_like(xt))
    hs = xt @ w_sh_gu
    shared = (jax.nn.silu(hs[:, :D_SHARED]) * hs[:, D_SHARED:]) @ w_sh_down
    return (routed + shared).reshape(b, s, d)


def setup_inputs(seed: int = 0) -> dict:
    key = jax.random.key(seed)
    ks = jax.random.split(key, 20)

    def nrm(k, shape, scale):
        return jax.random.normal(k, shape, jnp.float32) * scale

    return {
        'x': nrm(ks[0], (BATCH, SEQ, D_MODEL), 1.0),
        'w_in': nrm(ks[1], (DEPTH, D_MODEL, D_IN), D_MODEL ** -0.5),
        'b_forget': jax.random.uniform(ks[2], (DEPTH, GROUP_HEADS), jnp.float32, 1.0, 4.0),
        'mla_q_norm': 1.0 + nrm(ks[3], (DEPTH, Q_LORA), 0.02),
        'mla_kv_norm': 1.0 + nrm(ks[4], (DEPTH, KV_LORA), 0.02),
        'w_mla_uq': nrm(ks[5], (DEPTH, Q_LORA, GROUP_HEADS * (MLA_NOPE + MLA_ROPE)), Q_LORA ** -0.5),
        'w_mla_ukv': nrm(ks[6], (DEPTH, KV_LORA, GROUP_HEADS * (MLA_NOPE + MLA_V)), KV_LORA ** -0.5),
        't5_rel_bias': nrm(ks[7], (T5_BUCKETS, GROUP_HEADS), 0.5),
        'chunk_rel_bias': nrm(ks[8], (DEPTH, GROUP_HEADS, 2 * MAX_REL + 1), 0.5),
        'w_out': nrm(ks[9], (DEPTH, D_MIX, D_MODEL), BETA * D_MIX ** -0.5),
        'ln1_g': 1.0 + nrm(ks[10], (DEPTH, D_MODEL), 0.02),
        'ln1_b': nrm(ks[11], (DEPTH, D_MODEL), 0.02),
        'w_router': nrm(ks[12], (DEPTH, D_MODEL, N_EXPERTS), D_MODEL ** -0.5),
        'router_bias': nrm(ks[13], (DEPTH, N_EXPERTS), 0.01),
        'w_exp_gu': nrm(ks[14], (DEPTH, N_EXPERTS, D_MODEL, 2 * D_EXPERT), D_MODEL ** -0.5),
        'w_exp_down': nrm(ks[15], (DEPTH, N_EXPERTS, D_EXPERT, D_MODEL), BETA * D_EXPERT ** -0.5),
        'w_sh_gu': nrm(ks[16], (DEPTH, D_MODEL, 2 * D_SHARED), D_MODEL ** -0.5),
        'w_sh_down': nrm(ks[17], (DEPTH, D_SHARED, D_MODEL), BETA * D_SHARED ** -0.5),
        'ln2_g': 1.0 + nrm(ks[18], (DEPTH, D_MODEL), 0.02),
        'ln2_b': nrm(ks[19], (DEPTH, D_MODEL), 0.02),
    }


def reference(x, w_in, b_forget, mla_q_norm, mla_kv_norm, w_mla_uq, w_mla_ukv, t5_rel_bias,
              chunk_rel_bias, w_out, ln1_g, ln1_b, w_router, router_bias, w_exp_gu, w_exp_down,
              w_sh_gu, w_sh_down, ln2_g, ln2_b):
    pos = jnp.arange(x.shape[1])
    for layer in range(DEPTH):
        (fox_qkv, fox_f, dsa_qkv, idx_q, idx_k, idx_w,
         c_q, c_kv, k_r, band_qkv) = jnp.split(x @ w_in[layer], IN_SPLITS, axis=-1)
        mixed = jnp.concatenate([
            _fox_group(fox_qkv, fox_f, b_forget[layer]),
            _dsa_group(dsa_qkv, idx_q, idx_k, idx_w, t5_rel_bias),
            _mla_group(c_q, c_kv, k_r, mla_q_norm[layer], mla_kv_norm[layer],
                       w_mla_uq[layer], w_mla_ukv[layer], pos),
            _chunk_band_group(band_qkv, chunk_rel_bias[layer]),
        ], axis=-1)
        x = _layer_norm(ALPHA * x + mixed @ w_out[layer], ln1_g[layer], ln1_b[layer])
        ffn = _moe(x, w_router[layer], router_bias[layer], w_exp_gu[layer], w_exp_down[layer],
                   w_sh_gu[layer], w_sh_down[layer])
        x = _layer_norm(ALPHA * x + ffn, ln2_g[layer], ln2_b[layer])
    return x
```

```cpp
#include <hip/hip_runtime.h>
#include <cstdio>
#include <cstdint>
#include <cmath>

#define GAS __attribute__((address_space(1)))
#define LAS __attribute__((address_space(3)))
typedef unsigned short bf16;
typedef unsigned v4u __attribute__((ext_vector_type(4)));
typedef unsigned v2u __attribute__((ext_vector_type(2)));
typedef float f32x4 __attribute__((ext_vector_type(4)));
typedef float f32x2 __attribute__((ext_vector_type(2)));
typedef float f32x16 __attribute__((ext_vector_type(16)));
typedef short bf16x8 __attribute__((ext_vector_type(8)));
typedef short s16x4 __attribute__((ext_vector_type(4)));
typedef GAS unsigned gu32;
#define RLX_AGENT __ATOMIC_RELAXED, __HIP_MEMORY_SCOPE_AGENT
#define LDS_WAIT() asm volatile("s_waitcnt lgkmcnt(0)" ::: "memory")
#define VM_WAIT() asm volatile("s_waitcnt vmcnt(0)" ::: "memory")

constexpr int DM = 1024, NB = 16, SEQ = 2048, DEPTH = 4, NT = NB * SEQ;
constexpr int NPROJ = 3072;
constexpr int NE = 64, TOPK = 8, DEXP = 256;
constexpr int PC_FOX = 0, PC_DSA = 768, PC_BAND = 1536, PC_IQ = 2304, PC_CQ = 2560, PC_CKV = 2752, PC_KR = 2880, PC_IK = 2912, PC_IW = 2944, PC_FF = 2952, PC_END = 2956;
constexpr float LOG2E = 1.4426950408889634f;
constexpr float QSCALE64 = 0.125f * LOG2E;
constexpr float QSCALE96 = 0.10206207261596575f * LOG2E;
constexpr float ALPHA = 1.6817928305074290f;
constexpr float LN_EPS = 1e-5f, RMS_EPS = 1e-6f;
#ifndef YFP8
#define YFP8 1
#endif
constexpr float YSCALE = 64.0f, YINV = 1.0f / 64.0f;

constexpr size_t MiB = 1u << 20;
constexpr size_t WS_CTL = 0, CTL_ZERO_BYTES = 1 * MiB;
constexpr size_t WS_XB = 1 * MiB;
constexpr size_t WS_PROJ = 65 * MiB;
constexpr size_t WS_AUX = 257 * MiB;
constexpr size_t WS_QMLA = 259 * MiB;
constexpr size_t WS_KMLA = 283 * MiB;
constexpr size_t WS_VMLA = 307 * MiB;
constexpr size_t WS_CUM = 323 * MiB;
constexpr size_t WS_KNORM = WS_CUM + 512 * 1024;
constexpr size_t WS_MASK = 324 * MiB;
constexpr size_t WS_MIXED = 332 * MiB;
constexpr size_t WS_Y1 = 396 * MiB;
constexpr size_t WS_LIST = 460 * MiB;
constexpr size_t WS_GATE = 468 * MiB;
constexpr size_t WS_ABUF = 469 * MiB;
constexpr size_t WS_YBUF = 629 * MiB;
constexpr size_t WS_WIN = 1237 * MiB;
constexpr size_t WS_WOUT = 1261 * MiB;
constexpr size_t WS_WGU = 1269 * MiB;
constexpr size_t WS_WDN = 1529 * MiB;
constexpr size_t WS_WUQ = 1659 * MiB;
constexpr size_t WS_WUKV = 1660 * MiB;
constexpr size_t WS_WRH = 1661 * MiB;
constexpr size_t WS_WRL = 1662 * MiB;
constexpr size_t WS_IK = 1663 * MiB;
constexpr size_t WS_SREF = 1665 * MiB;
constexpr size_t WS_END = 1666 * MiB;
static_assert(WS_YBUF + (size_t)311296 * 1024 * 2 <= WS_WIN && WS_ABUF + (size_t)311296 * 256 * 2 <= WS_YBUF, "ws map");
static_assert(WS_WGU + (size_t)4 * 65 * 512 * 1024 * 2 <= WS_WDN && WS_WDN + (size_t)4 * 65 * 1024 * 256 * 2 <= WS_WUQ, "ws map w");
constexpr int CW_TMO = 0, CW_CODE = 1;
constexpr int CW_BAR = 4096;
constexpr int CW_Q = 8192;
constexpr int CW_CNT = 16384;
constexpr int RING_BYTES = 131072;
constexpr int LIST_OFF = RING_BYTES;
constexpr int OFFS_OFF = RING_BYTES + 3072;
constexpr int LDSCTL_OFF = RING_BYTES + 6144, MISC_OFF = LDSCTL_OFF;
constexpr int GRP_OFF = MISC_OFF + 256;
constexpr int LDS_BYTES = 147456;
static_assert(GRP_OFF + 512 <= LDS_BYTES, "LDS map");

__device__ __forceinline__ unsigned f2bf(float f) { unsigned u = __builtin_bit_cast(unsigned, f); return (u + 0x7fffu + ((u >> 16) & 1u)) >> 16; }

__device__ __forceinline__ float bf2f(unsigned h) { return __builtin_bit_cast(float, h << 16); }
__device__ __forceinline__ float bflo(unsigned w) { return __builtin_bit_cast(float, w << 16); }
__device__ __forceinline__ float bfhi(unsigned w) { return __builtin_bit_cast(float, w & 0xffff0000u); }
typedef float f32x2_t __attribute__((ext_vector_type(2))); typedef __bf16 bf16x2_t __attribute__((ext_vector_type(2)));
__device__ __forceinline__ unsigned cvt_pk_bf16(float lo, float hi) { f32x2_t v = {lo, hi}; bf16x2_t b = __builtin_convertvector(v, bf16x2_t); return __builtin_bit_cast(unsigned, b); }
__device__ __forceinline__ unsigned pk2(float lo, float hi) { return cvt_pk_bf16(lo, hi); }
__device__ __forceinline__ float fmul_s(float a, float b) { float r; asm("v_mul_f32_e32 %0, %1, %2" : "=v"(r) : "v"(a), "v"(b)); return r; }
__device__ __forceinline__ float ffma_s(float a, float b, float c) { float r; asm("v_fma_f32 %0, %1, %2, %3" : "=v"(r) : "v"(a), "v"(b), "v"(c)); return r; }
__device__ __forceinline__ float fadd_s(float a, float b) { float r; asm("v_add_f32_e32 %0, %1, %2" : "=v"(r) : "v"(a), "v"(b)); return r; }
__device__ __forceinline__ float fmax0_s(float a) { float r; asm("v_max_f32_e32 %0, 0, %1" : "=v"(r) : "v"(a)); return r; }
#define DPP_ADD_F(v, CTRL) ((v) + __builtin_bit_cast(float, __builtin_amdgcn_update_dpp(0, __builtin_bit_cast(int, (v)), (CTRL), 0xF, 0xF, true)))
__device__ __forceinline__ float wave_sum(float v) {
    v = DPP_ADD_F(v, 0xB1); v = DPP_ADD_F(v, 0x4E); v = DPP_ADD_F(v, 0x141); v = DPP_ADD_F(v, 0x140);
    { auto r = __builtin_amdgcn_permlane16_swap(__builtin_bit_cast(unsigned, v), __builtin_bit_cast(unsigned, v), false, false); const unsigned a_ = r[0], b_ = r[1]; v = __uint_as_float(a_) + __uint_as_float(b_); }
    { auto r = __builtin_amdgcn_permlane32_swap(__builtin_bit_cast(unsigned, v), __builtin_bit_cast(unsigned, v), false, false); const unsigned a_ = r[0], b_ = r[1]; v = __uint_as_float(a_) + __uint_as_float(b_); }
    return v;
}
#define DPP_MAX_F(v, CTRL) fmaxf((v), __builtin_bit_cast(float, __builtin_amdgcn_update_dpp(0, __builtin_bit_cast(int, (v)), (CTRL), 0xF, 0xF, true)))
__device__ __forceinline__ float wave_max_nn(float v) {
    v = DPP_MAX_F(v, 0xB1); v = DPP_MAX_F(v, 0x4E); v = DPP_MAX_F(v, 0x141); v = DPP_MAX_F(v, 0x140);
    { auto r = __builtin_amdgcn_permlane16_swap(__builtin_bit_cast(unsigned, v), __builtin_bit_cast(unsigned, v), false, false); const unsigned a_ = r[0], b_ = r[1]; v = fmaxf(__uint_as_float(a_), __uint_as_float(b_)); }
    { auto r = __builtin_amdgcn_permlane32_swap(__builtin_bit_cast(unsigned, v), __builtin_bit_cast(unsigned, v), false, false); const unsigned a_ = r[0], b_ = r[1]; v = fmaxf(__uint_as_float(a_), __uint_as_float(b_)); }
    return v;
}
__device__ __forceinline__ float swap32_add(float v) { auto r = __builtin_amdgcn_permlane32_swap(__builtin_bit_cast(unsigned, v), __builtin_bit_cast(unsigned, v), false, false); const unsigned a_ = r[0], b_ = r[1]; return __uint_as_float(a_) + __uint_as_float(b_); }
__device__ __forceinline__ float swap32_max(float v) { auto r = __builtin_amdgcn_permlane32_swap(__builtin_bit_cast(unsigned, v), __builtin_bit_cast(unsigned, v), false, false); const unsigned a_ = r[0], b_ = r[1]; return fmaxf(__uint_as_float(a_), __uint_as_float(b_)); }

__device__ __forceinline__ int lane_id_now() { int l; asm volatile("v_mbcnt_lo_u32_b32 %0, -1, 0\n\tv_mbcnt_hi_u32_b32 %0, -1, %0" : "=v"(l)); return l; }
#define XB_TMO      128
#define XB_XCNT(j)  (256  + 64 * (j))
#define XB_XSUB(j)  (1280 + 64 * (j))
#define XB_XGEN(j)  (2304 + 64 * (j))
#define XB_TOP      3328
#define XB_TOPGEN   3392
#define XCD_BAR_WORDS 3456
#define XB_SPIN_CAP (1u << 23)
__device__ __forceinline__ unsigned xb_ld(unsigned* p)              { return __hip_atomic_load(p, __ATOMIC_RELAXED, __HIP_MEMORY_SCOPE_AGENT); }
__device__ __forceinline__ unsigned xb_add(unsigned* p, unsigned v) { return __hip_atomic_fetch_add(p, v, __ATOMIC_RELAXED, __HIP_MEMORY_SCOPE_AGENT); }
__device__ __forceinline__ unsigned xb_xcc_id() { return (unsigned)__builtin_amdgcn_s_getreg((3 << 11) | 20) & 0xFu; }
#define XB_SPIN(cond, bar) do { unsigned _sp = 0; while (cond) { __builtin_amdgcn_s_sleep(1); \
    if ((++_sp & 255u) == 0u) { if (xb_ld(&(bar)[XB_TMO])) break; if (_sp > XB_SPIN_CAP) { atomicAdd(&(bar)[XB_TMO], 1u); break; } } } } while (0)
struct XcdBarrier { unsigned* bar; unsigned x; volatile LAS unsigned* st; };
__device__ __forceinline__ XcdBarrier xcd_barrier_post(unsigned* bar, volatile LAS unsigned* st, bool leader) {
    XcdBarrier b; b.bar = bar; b.x = xb_xcc_id(); b.st = st;
    if (leader) (void)xb_add(&bar[XB_XCNT(b.x)], 1u);
    return b;
}
__device__ __forceinline__ void xcd_barrier_complete(unsigned* bar, unsigned x, unsigned& nloc, unsigned& nx) {
    const unsigned G = gridDim.x * gridDim.y * gridDim.z;
    unsigned sum, cnt, mine, sp = 0u;
    for (;;) {
        sum = 0u; cnt = 0u; mine = 0u;
#pragma unroll
        for (unsigned j = 0; j < 16; ++j) { const unsigned c = xb_ld(&bar[XB_XCNT(j)]); sum += c; cnt += (c > 0u) ? 1u : 0u; mine = (j == x) ? c : mine; }
        if (sum == G) break;
        __builtin_amdgcn_s_sleep(1);
        if ((++sp & 255u) == 0u) { if (xb_ld(&bar[XB_TMO])) break; if (sp > XB_SPIN_CAP) { atomicAdd(&bar[XB_TMO], 1u); break; } }
    }
    nloc = mine > 0u ? mine : 1u; nx = cnt > 0u ? cnt : 1u;
}
__device__ __forceinline__ void xcd_barrier(const XcdBarrier& b, bool leader) {
    asm volatile("s_waitcnt vmcnt(0)" ::: "memory");
    __syncthreads();
    if (leader) {
        unsigned* bar = b.bar; unsigned bx_ = b.x;
        asm volatile("" : "+s"(bar), "+s"(bx_));
        __builtin_amdgcn_s_waitcnt(0);
        unsigned nloc = b.st[0], nx = b.st[1];
        if (nloc == 0u) { xcd_barrier_complete(bar, bx_, nloc, nx); b.st[0] = nloc; b.st[1] = nx; }
        const unsigned old = xb_add(&bar[XB_XSUB(bx_)], 1u);
        const unsigned gen = old / nloc;
        if (old + 1u == (gen + 1u) * nloc) {
            __builtin_amdgcn_fence(__ATOMIC_RELEASE, "agent");
            asm volatile("s_waitcnt vmcnt(0)" ::: "memory");
            const unsigned og = xb_add(&bar[XB_TOP], 1u);
            const unsigned tg = og / nx;
            if (og + 1u == (tg + 1u) * nx) xb_add(&bar[XB_TOPGEN], 1u);
            else XB_SPIN(xb_ld(&bar[XB_TOPGEN]) == tg, bar);
            __builtin_amdgcn_fence(__ATOMIC_ACQUIRE, "agent");
            xb_add(&bar[XB_XGEN(bx_)], 1u);
            asm volatile("s_waitcnt vmcnt(0)" ::: "memory");
        } else {
            XB_SPIN(xb_ld(&bar[XB_XGEN(bx_)]) == gen, bar);
            __builtin_amdgcn_fence(__ATOMIC_ACQUIRE, "agent");
            asm volatile("s_waitcnt vmcnt(0)" ::: "memory");
        }
    }
    __syncthreads();
}
namespace pg8 {
constexpr int BM = 256, BK = 64, HALF = 128, HTB = HALF * BK * 2, STAGE_BYTES = 8 * HTB;
__host__ __device__ __forceinline__ int lds_byte(int r, int c) { const int st = (r >> 4) * 2 + (c >> 5), rr = r & 15, cc = c & 31, ob = rr * 64 + cc * 2; return st * 1024 + (ob ^ (((ob >> 9) & 1) << 5)); }
__host__ __device__ __forceinline__ void stage_rc(int b, int& R, int& C) { const int st = b / 1024, sb = b % 1024, swz = sb ^ (((sb >> 9) & 1) << 5); R = (st >> 1) * 16 + swz / 64; C = (st & 1) * 32 + (swz % 64) / 2; }
__host__ __device__ __forceinline__ int perm32(int rho) { const int n = rho >> 4, i = rho & 15; return 8 * (i >> 2) + 4 * n + (i & 3); }

struct Unit { int pm, pn, grp, cnt, sb; };

template <class Epi, class Sched, bool ALIGN_EPI>
__device__ __forceinline__ void gemm_phase(LAS unsigned char* lds, LAS int* lists  , LAS unsigned* offs  , const char* Abase, int K, const Sched& S, const Epi& E, int wave_u) {
    int tid_ = wave_u * 64 + lane_id_now();
    const int tid = tid_, wid = __builtin_amdgcn_readfirstlane(tid >> 6), lane = tid & 63, wr = wid >> 2, wc = wid & 3, fr = lane & 15, fq = lane >> 4;
    const int nt = K / BK;
    asm volatile("" : "+s"(Abase));
    int Rr[2]; unsigned Cb[2], voffB[2];
#pragma unroll
    for (int i = 0; i < 2; ++i) { int R, C; stage_rc(tid * 16 + i * 8192, R, C); int Rb = (R & ~31) + perm32(R & 31);
        if constexpr (Epi::COL16) Rb = 64 * (Rb >> 5) + 16 * ((Rb >> 3) & 3) + (Rb & 7);
        Rr[i] = R; Cb[i] = (unsigned)C * 2u; voffB[i] = (unsigned)(Rb * K + C) * 2u; }
    const size_t kstep = (size_t)(BK * 2);
    const size_t hstepB = (size_t)(Epi::COL16 ? 8 : HALF) * K * 2;
    const unsigned ldsw = (unsigned)wid * 1024u;
    const int aoff = lds_byte(wr * 64 + fr, fq * 8), boff = lds_byte(wc * 32 + fr, fq * 8);
#define PG8_SA(b, h) (((b) * 2 + (h)) * HTB)
#define PG8_SB(b, h) ((4 + (b) * 2 + (h)) * HTB)
#define PG8_STAGEB(bufoff, gbase) do { _Pragma("unroll") for (int _i = 0; _i < 2; ++_i) { unsigned vo_ = voffB[_i]; asm volatile("" : "+v"(vo_));   \
        __builtin_amdgcn_global_load_lds((const unsigned*)((const char*)(gbase) + vo_), (LAS unsigned*)(lds + (bufoff) + ldsw + _i * 8192), 16, 0, 0); } } while (0)
#define PG8_LDA(dst, b, h) do { _Pragma("unroll") for (int m = 0; m < 4; ++m) _Pragma("unroll") for (int k = 0; k < 2; ++k) dst[m][k] = *(const LAS bf16x8*)(lds + PG8_SA(b, h) + aoff + m * 2048 + k * 1024); } while (0)
#define PG8_LDB(dst, b, h) do { _Pragma("unroll") for (int n = 0; n < 2; ++n) _Pragma("unroll") for (int k = 0; k < 2; ++k) dst[n][k] = *(const LAS bf16x8*)(lds + PG8_SB(b, h) + boff + n * 2048 + k * 1024); } while (0)
#define PG8_MMA(ai, bj, At, Bt) do { __builtin_amdgcn_s_setprio(1); _Pragma("unroll") for (int m = 0; m < 4; ++m) _Pragma("unroll") for (int n = 0; n < 2; ++n) _Pragma("unroll") for (int k = 0; k < 2; ++k) \
        acc[ai][bj][m][n] = __builtin_amdgcn_mfma_f32_16x16x32_bf16(Bt[n][k], At[m][k], acc[ai][bj][m][n], 0, 0, 0); __builtin_amdgcn_s_setprio(0); } while (0)
#define PG8_WAIT_V(n) asm volatile("s_waitcnt vmcnt(" #n ")" ::: "memory")
#define PG8_WAIT_L(n) asm volatile("s_waitcnt lgkmcnt(" #n ")" ::: "memory")
#define PG8_BAR __builtin_amdgcn_s_barrier()
#define PG8_SCHED __builtin_amdgcn_sched_barrier(0)
    Unit cur, nxt; int ui = 0;
    if (!S.next(0, cur)) return;
    unsigned voffA[2] = {0u, 0u};
    size_t cAu = 0, nAu = 0; const size_t hstepA = (size_t)HALF * S.lda2;
    if constexpr (!Sched::GATHER) {
#pragma unroll
        for (int i = 0; i < 2; ++i) voffA[i] = (unsigned)Rr[i] * S.lda2 + Cb[i];
        cAu = (size_t)S.arow(cur, 0, 0);
    }
    unsigned Rb4[2] = {0u, 0u};
    if constexpr (Sched::LIST) {
        if (wid == 0) __builtin_amdgcn_global_load_lds((const unsigned*)(S.list_ptr(cur) + lane * 4), (LAS unsigned*)(lists), 16, 0, 0);
        PG8_WAIT_V(0); __syncthreads();
    }
    if constexpr (Sched::GATHER) {
#pragma unroll
        for (int i = 0; i < 2; ++i) Rb4[i] = (unsigned)Rr[i] * 4u;
        if (tid < 256) offs[tid] = S.arow(cur, tid, lists[tid]);
        __syncthreads();
    }
#define PG8_APRE(h, OT) unsigned ao_[2]; do { _Pragma("unroll") for (int _i = 0; _i < 2; ++_i) { if constexpr (Sched::GATHER) ao_[_i] = *(const LAS unsigned*)((const LAS unsigned char*)(OT) + (h) * (HALF * 4) + Rb4[_i]) + Cb[_i]; else ao_[_i] = voffA[_i]; } } while (0)
#define PG8_STAGEA(bufoff, UBASE, h, kb) do { const char* ub_ = Sched::GATHER ? (Abase + (size_t)(kb)) : (Abase + (UBASE) + (h) * hstepA + (size_t)(kb)); _Pragma("unroll") for (int _i = 0; _i < 2; ++_i) { unsigned vo_ = ao_[_i]; asm volatile("" : "+v"(vo_)); \
        __builtin_amdgcn_global_load_lds((const unsigned*)(ub_ + vo_), (LAS unsigned*)(lds + (bufoff) + ldsw + _i * 8192), 16, 0, 0); } } while (0)
    f32x4 acc[2][2][4][2];
#pragma unroll
    for (int a = 0; a < 2; ++a)
#pragma unroll
        for (int b = 0; b < 2; ++b)
#pragma unroll
            for (int m = 0; m < 4; ++m)
#pragma unroll
                for (int n = 0; n < 2; ++n) acc[a][b][m][n] = (f32x4){0.f, 0.f, 0.f, 0.f};
    bf16x8 At[4][2], B0[2][2], B1[2][2];
    const char* cB = S.bptr(cur); asm volatile("" : "+s"(cB));
    { PG8_APRE(0, offs); PG8_STAGEB(PG8_SB(0, 0), cB); PG8_STAGEB(PG8_SB(0, 1), cB + hstepB); PG8_STAGEA(PG8_SA(0, 0), cAu, 0, 0); }
    { PG8_APRE(1, offs); PG8_STAGEA(PG8_SA(0, 1), cAu, 1, 0); }
    if (wr == 1) PG8_BAR;
    PG8_WAIT_V(2); PG8_BAR;
    { PG8_APRE(0, offs); PG8_STAGEB(PG8_SB(1, 0), cB + kstep); PG8_STAGEA(PG8_SA(1, 0), cAu, 0, kstep); PG8_STAGEB(PG8_SB(1, 1), cB + hstepB + kstep); }
    PG8_WAIT_V(6); PG8_BAR;
#define PG8_TRIP(ON, NUB, k1, k2, k3, b2, b3, PRE) do { \
            { PG8_APRE(1, ocur); PRE; PG8_LDB(B0, 0, 0); PG8_LDB(B1, 0, 1); PG8_SCHED; PG8_LDA(At, 0, 0); PG8_STAGEA(PG8_SA(1, 1), cAu, 1, k1); } \
            PG8_WAIT_V(8); PG8_WAIT_L(0); PG8_BAR; PG8_MMA(0, 0, At, B0); PG8_MMA(0, 1, At, B1); PG8_BAR; PG8_SCHED; \
            { PG8_APRE(0, ON); PG8_LDA(At, 0, 1); PG8_STAGEB(PG8_SB(0, 0), b2); PG8_STAGEB(PG8_SB(0, 1), b2 + hstepB); PG8_STAGEA(PG8_SA(0, 0), NUB, 0, k2); } \
            PG8_WAIT_V(8); PG8_WAIT_L(0); PG8_BAR; PG8_MMA(1, 0, At, B0); PG8_MMA(1, 1, At, B1); PG8_BAR; PG8_SCHED; \
            { PG8_APRE(1, ON); PG8_LDB(B0, 1, 0); PG8_LDB(B1, 1, 1); PG8_SCHED; PG8_LDA(At, 1, 0); PG8_STAGEA(PG8_SA(0, 1), NUB, 1, k2); } \
            PG8_WAIT_V(8); PG8_WAIT_L(0); PG8_BAR; PG8_MMA(0, 0, At, B0); PG8_MMA(0, 1, At, B1); PG8_BAR; PG8_SCHED; \
            { PG8_APRE(0, ON); PG8_LDA(At, 1, 1); PG8_STAGEB(PG8_SB(1, 0), b3); PG8_STAGEB(PG8_SB(1, 1), b3 + hstepB); PG8_STAGEA(PG8_SA(1, 0), NUB, 0, k3); } \
            PG8_WAIT_V(8); PG8_WAIT_L(0); PG8_BAR; PG8_MMA(1, 0, At, B0); PG8_MMA(1, 1, At, B1); PG8_BAR; PG8_SCHED; } while (0)
    for (;;) {
        const bool has_next = S.next(ui + 1, nxt);
        const char* nB = has_next ? S.bptr(nxt) : cB; asm volatile("" : "+s"(nB));
        LAS int* lcur = lists + (ui % 3) * 256; LAS int* lnxt = lists + ((ui + 1) % 3) * 256;
        LAS unsigned* ocur = offs + (ui % 3) * 256; LAS unsigned* onxt = offs + ((ui + 1) % 3) * 256;
        if constexpr (Sched::LIST) { if (has_next && wid == 0) __builtin_amdgcn_global_load_lds((const unsigned*)(S.list_ptr(nxt) + lane_id_now() * 4), (LAS unsigned*)(lnxt), 16, 0, 0); }
        for (int t = 0; t < nt - 2; t += 2) {
            const size_t k1 = (size_t)(t + 1) * kstep, k2 = (size_t)(t + 2) * kstep, k3 = k2 + kstep;
            const char* b2 = cB + k2; const char* b3 = b2 + kstep;
            PG8_TRIP(ocur, cAu, k1, k2, k3, b2, b3, (void)0);
        }
        {
            if (!has_next) { nxt = cur; lnxt = lcur; }
            if constexpr (!Sched::GATHER) nAu = (size_t)S.arow(nxt, 0, 0);
            const size_t k1 = (size_t)(nt - 1) * kstep;
            const char* b2 = nB; const char* b3 = nB + kstep;
            PG8_TRIP(onxt, nAu, k1, (size_t)0, kstep, b2, b3, do { if constexpr (Sched::GATHER) { if (wr == 0) { const int t3_ = wave_u * 64 + lane_id_now(); onxt[t3_] = S.arow(nxt, t3_, lnxt[t3_]); } } } while (0));
            if constexpr (ALIGN_EPI) { if (wr == 0) PG8_BAR; }
            asm volatile("" ::: "memory"); __builtin_amdgcn_sched_barrier(0);
            { const int ln2_ = lane_id_now();
              E(acc, cur, lcur, wr, wc, ln2_ & 15, ln2_ >> 4); }
            asm volatile("" ::: "memory"); __builtin_amdgcn_sched_barrier(0);
            if (!has_next) break;
            cAu = nAu;
        }
#pragma unroll
        for (int a = 0; a < 2; ++a)
#pragma unroll
            for (int b = 0; b < 2; ++b)
#pragma unroll
                for (int m = 0; m < 4; ++m)
#pragma unroll
                    for (int n = 0; n < 2; ++n) acc[a][b][m][n] = (f32x4){0.f, 0.f, 0.f, 0.f};
        cur = nxt; cB = nB; ++ui;
        if constexpr (ALIGN_EPI) { if (wr == 1) PG8_BAR; }
    }
    PG8_WAIT_V(0);
    if constexpr (!ALIGN_EPI) { if (wr == 0) PG8_BAR; }
    PG8_BAR;
#undef PG8_TRIP
#undef PG8_APRE
#undef PG8_STAGEA
#undef PG8_SA
#undef PG8_SB
#undef PG8_STAGEB
#undef PG8_LDA
#undef PG8_LDB
#undef PG8_MMA
#undef PG8_WAIT_V
#undef PG8_WAIT_L
#undef PG8_BAR
#undef PG8_SCHED
}
}
namespace pg8 {
struct DenseOrder {
    static constexpr bool GATHER = false, LIST = false;
    const char* Bt; int nM, nN, nwg, G, c, K; unsigned lda2;
    __device__ __forceinline__ void init(const void* Bt_, int M, int N, int K_, int lda_elems, int G_, int c_) { Bt = (const char*)Bt_; nM = M / BM; nN = N / BM; nwg = nM * nN; G = G_; c = c_; K = K_; lda2 = (unsigned)lda_elems * 2u; }
    __device__ __forceinline__ bool next(int i, Unit& u) const {
        const int L = i * G + c; if (L >= nwg) return false;
        const int nig = 8 * nN, gid = L / nig, r = L % nig;
        u.pm = gid * 8 + (r & 7); u.pn = r >> 3; u.grp = 0; u.cnt = 1 << 30; u.sb = 0; return true;
    }
    __device__ __forceinline__ const char* bptr(const Unit& u) const { return Bt + (size_t)u.pn * BM * K * 2; }
    __device__ __forceinline__ const int* list_ptr(const Unit&) const { return nullptr; }
    __device__ __forceinline__ unsigned arow(const Unit& u, int row, int) const { return (unsigned)(u.pm * BM + row) * lda2; }
};
template <int MODE>
struct GroupedOrder {
    static constexpr bool GATHER = (MODE == 0), LIST = (MODE == 0);
    const char* Bt; const int* list; int nN, G, c, K, N; unsigned lda2;
    LAS unsigned* lpre; LAS unsigned* lcnt; int total;
    __device__ __forceinline__ void init(const void* Bt_, const int* list_, const unsigned* counts, int N_, int K_, int lda_elems, int G_, int c_, int lane_, LAS unsigned* grp) {
        Bt = (const char*)Bt_; list = list_; N = N_; nN = N_ / BM; K = K_; G = G_; c = c_; lda2 = (unsigned)lda_elems * 2u; const int lane = lane_; lpre = grp; lcnt = grp + 64;
        unsigned cnt_lane = __hip_atomic_load(counts + lane, __ATOMIC_RELAXED, __HIP_MEMORY_SCOPE_AGENT);
        if (cnt_lane > (unsigned)NT) cnt_lane = NT;
        const unsigned nt_ = (cnt_lane + 255u) >> 8; unsigned pre = 0u; int tot = 0;
#pragma unroll
        for (int j = 0; j < 64; ++j) { const int v = __builtin_amdgcn_readlane((int)nt_, j); pre += (j < lane) ? (unsigned)v : 0u; tot += v; }
        total = tot;
        lpre[lane] = pre; lcnt[lane] = cnt_lane;
        __syncthreads();
    }
    __device__ __forceinline__ bool next(int i, Unit& u) const {
        const int L = i * G + c, t = L / nN; u.pn = L % nN;
        const int nsh = NT / BM;
        if (t >= nsh + total) return false;
        if (t < nsh) { u.grp = 64; u.pm = t; u.cnt = NT; u.sb = 256 * (total + t); return true; }
        const int tt = t - nsh;
        const unsigned long long m = __ballot(lpre[lane_id_now()] <= (unsigned)tt);
        const int g = __popcll(m) - 1;
        const int pg_ = __builtin_amdgcn_readfirstlane((int)lpre[g]); u.grp = g; u.pm = tt - pg_; u.cnt = __builtin_amdgcn_readfirstlane((int)lcnt[g]); u.sb = 256 * tt; return true;
    }
    __device__ __forceinline__ const char* bptr(const Unit& u) const { return Bt + ((size_t)u.grp * N + (size_t)u.pn * BM) * K * 2; }
    __device__ __forceinline__ const int* list_ptr(const Unit& u) const { return list + (size_t)(u.grp & 63) * NT + u.pm * BM; }
    __device__ __forceinline__ int rid_of(const Unit& u, int row, int rid_list) const {
        const int r = u.pm * BM + row;
        if (u.grp == 64) return 8 * NT + r;
        return (r < u.cnt) ? (rid_list & 0x3ffff) : 0;
    }
    __device__ __forceinline__ unsigned arow(const Unit& u, int row, int rid_list) const {
        if (MODE == 1) return (unsigned)(u.sb + row) * lda2;
        const int rid = rid_of(u, row, rid_list);
        const int tok = (rid >= 8 * NT) ? rid - 8 * NT : (rid >> 3); return (unsigned)tok * lda2;
    }
};

struct EpiProj {
    static constexpr bool COL16 = false;
    bf16* proj; float* aux; bf16* ik;
    __device__ __forceinline__ void operator()(const f32x4 (&acc)[2][2][4][2], const Unit& u, LAS int*, int wr, int wc, int fr, int fq) const {
        const int row0 = u.pm * BM + wr * 64 + fr, col0 = u.pn * BM + wc * 32 + 8 * fq;
#pragma unroll
        for (int ai = 0; ai < 2; ++ai)
#pragma unroll
            for (int m = 0; m < 4; ++m) { const int row = row0 + ai * HALF + m * 16; bf16* rowp = proj + (size_t)row * NPROJ + col0;
#pragma unroll
                for (int bj = 0; bj < 2; ++bj) { const f32x4 v0 = acc[ai][bj][m][0], v1 = acc[ai][bj][m][1];
                    v4u w; w.x = cvt_pk_bf16(v0[0], v0[1]); w.y = cvt_pk_bf16(v0[2], v0[3]); w.z = cvt_pk_bf16(v1[0], v1[1]); w.w = cvt_pk_bf16(v1[2], v1[3]);
                    *(v4u*)(rowp + bj * HALF) = w;
                    if (u.pn == 11 && bj == 0 && wc == 3) *(v4u*)(ik + (size_t)row * 32 + 8 * fq) = w;
                    if (u.pn == 11 && bj == 1 && wc == 0 && fq < 2) {
                        float* ap = aux + (size_t)row * 16 + 8 * fq; *(f32x4*)ap = v0; *(f32x4*)(ap + 4) = v1; } }
                asm volatile("" ::: "memory"); __builtin_amdgcn_sched_barrier(0); }
    }
};
struct EpiOut {
    static constexpr bool COL16 = false;
    const bf16* xb; bf16* y1;
    __device__ __forceinline__ void operator()(const f32x4 (&acc)[2][2][4][2], const Unit& u, LAS int*, int wr, int wc, int fr, int fq) const {
        const int row0 = u.pm * BM + wr * 64 + fr, col0 = u.pn * BM + wc * 32 + 8 * fq;
#pragma unroll
        for (int ai = 0; ai < 2; ++ai) {
            v4u xv[4][2];
#pragma unroll
            for (int m = 0; m < 4; ++m)
#pragma unroll
                for (int bj = 0; bj < 2; ++bj) xv[m][bj] = *(const v4u*)(xb + (size_t)(row0 + ai * HALF + m * 16) * DM + col0 + bj * HALF);
#pragma unroll
            for (int m = 0; m < 4; ++m) { const size_t off = (size_t)(row0 + ai * HALF + m * 16) * DM + col0;
#pragma unroll
                for (int bj = 0; bj < 2; ++bj) { const v4u xq = xv[m][bj]; const f32x4 v0 = acc[ai][bj][m][0], v1 = acc[ai][bj][m][1];
                    v4u w; w.x = cvt_pk_bf16(v0[0] + ALPHA * bflo(xq.x), v0[1] + ALPHA * bfhi(xq.x)); w.y = cvt_pk_bf16(v0[2] + ALPHA * bflo(xq.y), v0[3] + ALPHA * bfhi(xq.y));
                    w.z = cvt_pk_bf16(v1[0] + ALPHA * bflo(xq.z), v1[1] + ALPHA * bfhi(xq.z)); w.w = cvt_pk_bf16(v1[2] + ALPHA * bflo(xq.w), v1[3] + ALPHA * bfhi(xq.w));
                    *(v4u*)(y1 + off + bj * HALF) = w; }
                asm volatile("" ::: "memory"); __builtin_amdgcn_sched_barrier(0); }
        }
    }
};
template <int MODE> struct EpiGU {
    static constexpr bool COL16 = false;
    const GroupedOrder<MODE>& S; bf16* abuf; const float* gate;
    __device__ __forceinline__ void operator()(const f32x4 (&acc)[2][2][4][2], const Unit& u, LAS int* lst, int wr, int wc, int fr, int fq) const {
        const int col0 = u.pn * HALF + wc * 32 + 8 * fq;
#pragma unroll
        for (int ai = 0; ai < 2; ++ai)
#pragma unroll
            for (int m = 0; m < 4; ++m) { const int row = ai * HALF + wr * 64 + m * 16 + fr; const int r = u.pm * BM + row;
                if (r < u.cnt) {
                    float o[8];
#pragma unroll
                    for (int n = 0; n < 2; ++n)
#pragma unroll
                        for (int j = 0; j < 4; ++j) { const float g = acc[ai][0][m][n][j], up = acc[ai][1][m][n][j]; const float sg = g * __builtin_amdgcn_rcpf(1.0f + __builtin_amdgcn_exp2f(-g * LOG2E)); o[4 * n + j] = sg * up; }
                    v4u w; w.x = cvt_pk_bf16(o[0], o[1]); w.y = cvt_pk_bf16(o[2], o[3]); w.z = cvt_pk_bf16(o[4], o[5]); w.w = cvt_pk_bf16(o[6], o[7]);
                    *(v4u*)(abuf + (size_t)(u.sb + row) * DEXP + col0) = w; }
                asm volatile("" ::: "memory"); __builtin_amdgcn_sched_barrier(0); }
    }
};
template <int MODE> struct EpiDown {
    static constexpr bool COL16 = true;
    const GroupedOrder<MODE>& S; bf16* ybuf; int nostore;
    __device__ __forceinline__ void operator()(const f32x4 (&acc)[2][2][4][2], const Unit& u, LAS int*, int wr, int wc, int fr, int fq) const {
        const int col0 = u.pn * BM + wc * 32 + 8 * fq; (void)col0;
#pragma unroll
        for (int ai = 0; ai < 2; ++ai)
#pragma unroll
            for (int m = 0; m < 4; ++m) { const int row = ai * HALF + wr * 64 + m * 16 + fr;
#if YFP8
                unsigned char* rowp = (unsigned char*)ybuf + (size_t)(u.sb + row) * DM + u.pn * BM + wc * 64 + 16 * fq;
#define Y8(x) __builtin_amdgcn_fmed3f((x) * YSCALE, -448.f, 448.f)
                int wv[4];
#pragma unroll
                for (int bj = 0; bj < 2; ++bj) { const f32x4 v0 = acc[ai][bj][m][0], v1 = acc[ai][bj][m][1];
                    int w0 = 0, w1 = 0;
                    w0 = __builtin_amdgcn_cvt_pk_fp8_f32(Y8(v0[0]), Y8(v0[1]), w0, false); w0 = __builtin_amdgcn_cvt_pk_fp8_f32(Y8(v0[2]), Y8(v0[3]), w0, true);
                    w1 = __builtin_amdgcn_cvt_pk_fp8_f32(Y8(v1[0]), Y8(v1[1]), w1, false); w1 = __builtin_amdgcn_cvt_pk_fp8_f32(Y8(v1[2]), Y8(v1[3]), w1, true);
                    wv[2 * bj] = w0; wv[2 * bj + 1] = w1; }
#undef Y8
                { v4u w; w.x = (unsigned)wv[0]; w.y = (unsigned)wv[1]; w.z = (unsigned)wv[2]; w.w = (unsigned)wv[3];
                  if (!nostore) *(v4u*)rowp = w; else asm volatile("" :: "v"(w)); }
#else
                bf16* rowp = ybuf + (size_t)(u.sb + row) * DM + u.pn * BM + wc * 64 + 16 * fq;
#pragma unroll
                for (int bj = 0; bj < 2; ++bj) { const f32x4 v0 = acc[ai][bj][m][0], v1 = acc[ai][bj][m][1];
                    v4u w; w.x = cvt_pk_bf16(v0[0], v0[1]); w.y = cvt_pk_bf16(v0[2], v0[3]); w.z = cvt_pk_bf16(v1[0], v1[1]); w.w = cvt_pk_bf16(v1[2], v1[3]);
                    if (!nostore) __builtin_nontemporal_store(w, (v4u*)(rowp + 8 * bj)); else asm volatile("" :: "v"(w)); }
#endif
                asm volatile("" ::: "memory"); __builtin_amdgcn_sched_barrier(0); }
    }
};
}
struct Args { const float* in[20]; float* out; unsigned char* ws; int ph_lo, ph_hi, rep, pad; };
struct Frame {
    LAS unsigned char* lds;
    volatile LAS unsigned* MISC;
    gu32* ctl;
    int tid, lane, wave, wave0, G, vcu, G0, vcu0;
    GAS unsigned char* ws; GAS unsigned char* ws0;
};
#define WSP(T, off) ((T*)(GAS T*)(F.ws + (off)))
#define UNIT_BEGIN() do { F.lane = lane_id_now(); F.wave = F.wave0; F.tid = F.wave0 * 64 + F.lane; { GAS unsigned char* w_ = F.ws0; asm volatile("" : "+s"(w_)); F.ws = w_; int g_ = F.G0, v_ = F.vcu0; asm volatile("" : "+s"(g_), "+s"(v_)); F.G = g_; F.vcu = v_; } } while (0)

__device__ __forceinline__ int win_srccol(int n) {
    if (n < 768) return n;
    if (n < 1536) return 772 + (n - 768);
    if (n < 2304) return 2188 + (n - 1536);
    if (n < 2560) return 1540 + (n - 2304);
    if (n < 2752) return 1836 + (n - 2560);
    if (n < 2880) return 2028 + (n - 2752);
    if (n < 2912) return 2156 + (n - 2880);
    if (n < 2944) return 1796 + (n - 2912);
    if (n < 2952) return 1828 + (n - 2944);
    if (n < 2956) return 768 + (n - 2952);
    return -1;
}
__device__ __forceinline__ float win_scale(int n) { return ((n < 256) || (n >= 768 && n < 1024) || (n >= 1536 && n < 1792)) ? QSCALE64 : 1.0f; }

template <int MODE>
__device__ __forceinline__ void cvt_item(const float* W, int ldw, bf16* WT, bf16* WT2, int ldt, int k0, int n0, const float* kvec, float sc, LAS float* scr, int lane) {
    const int nl = lane & 31, n = n0 + nl;
    int col = n; float s = 1.0f;
    if (MODE == 1) { col = win_srccol(n); s = win_scale(n); }
    if (MODE == 2) { const int pn = n >> 8, j = n & 255; col = (j < 128) ? (128 * pn + j) : (256 + 128 * pn + (j - 128)); }
#pragma unroll
    for (int i = 0; i < 32; ++i) { const int kk = 2 * i + (lane >> 5); float v = (col >= 0) ? W[(size_t)(k0 + kk) * ldw + col] : 0.0f;
        if (MODE == 1) v *= s;
        if (MODE == 3) v *= kvec[k0 + kk] * sc;
        scr[kk * 33 + nl] = v; }
    LDS_WAIT(); asm volatile("" ::: "memory");
    const int c = lane & 7;
#pragma unroll
    for (int j = 0; j < 4; ++j) { const int nn = (lane >> 3) + 8 * j; const LAS float* sp = scr + (8 * c) * 33 + nn;
        float v[8];
#pragma unroll
        for (int q = 0; q < 8; ++q) v[q] = sp[q * 33];
        v4u o; o.x = pk2(v[0], v[1]); o.y = pk2(v[2], v[3]); o.z = pk2(v[4], v[5]); o.w = pk2(v[6], v[7]);
        if (MODE == 3) *(GAS v4u*)(WT + ((size_t)((k0 >> 3) + c) * ldt + (n0 + nn)) * 8) = o;
        else *(GAS v4u*)(WT + (size_t)(n0 + nn) * ldt + k0 + 8 * c) = o;
        if (MODE == 4) {
            float r[8];
#pragma unroll
            for (int q = 0; q < 8; ++q) r[q] = v[q] - bf2f(f2bf(v[q]));
            v4u o2; o2.x = pk2(r[0], r[1]); o2.y = pk2(r[2], r[3]); o2.z = pk2(r[4], r[5]); o2.w = pk2(r[6], r[7]);
            *(GAS v4u*)(WT2 + (size_t)(n0 + nn) * ldt + k0 + 8 * c) = o2; } }
    LDS_WAIT(); asm volatile("" ::: "memory");
}

__device__ __forceinline__ void p0_prologue(Frame& F, const Args& A) {
    LAS float* scr = (LAS float*)(F.lds + F.wave * 16384);
    const int gw = F.vcu * 8 + F.wave, NGW = F.G * 8;
    constexpr int I0 = 4 * 16 * 96, I1 = 4 * 16 * 32, I2 = 256 * 256, I3 = 4 * 256, I4 = 256 * 128, I5 = 4 * 128, I6 = 4 * 36, I7 = 4 * 32, I8 = 4 * 32;
    constexpr int NITEMS = I0 + I1 + I2 + I3 + I4 + I5 + I6 + I7 + I8;
    for (int it = gw; it < NITEMS; it += NGW) {
        int r = it;
        if (r < I0) { const int l = r / 1536, q = r % 1536, kb = q / 96, nb = q % 96;
            cvt_item<1>(A.in[1] + (size_t)l * 1024 * 2956, 2956, WSP(bf16, WS_WIN) + (size_t)l * NPROJ * 1024, nullptr, 1024, 64 * kb, 32 * nb, nullptr, 1.f, scr, F.lane); continue; } r -= I0;
        if (r < I1) { const int l = r / 512, q = r % 512, kb = q / 32, nb = q % 32;
            cvt_item<0>(A.in[9] + (size_t)l * 1024 * 1024, 1024, WSP(bf16, WS_WOUT) + (size_t)l * 1024 * 1024, nullptr, 1024, 64 * kb, 32 * nb, nullptr, 1.f, scr, F.lane); continue; } r -= I1;
        if (r < I2) { const int le = r / 256, q = r % 256, kb = q / 16, nb = q % 16, l = le >> 6, e = le & 63;
            cvt_item<2>(A.in[14] + (size_t)le * 1024 * 512, 512, WSP(bf16, WS_WGU) + ((size_t)l * 65 + e) * 512 * 1024, nullptr, 1024, 64 * kb, 32 * nb, nullptr, 1.f, scr, F.lane); continue; } r -= I2;
        if (r < I3) { const int l = r / 256, q = r % 256, kb = q / 16, nb = q % 16;
            cvt_item<2>(A.in[16] + (size_t)l * 1024 * 512, 512, WSP(bf16, WS_WGU) + ((size_t)l * 65 + 64) * 512 * 1024, nullptr, 1024, 64 * kb, 32 * nb, nullptr, 1.f, scr, F.lane); continue; } r -= I3;
        if (r < I4) { const int le = r / 128, q = r % 128, kb = q / 32, nb = q % 32, l = le >> 6, e = le & 63;
            cvt_item<0>(A.in[15] + (size_t)le * 256 * 1024, 1024, WSP(bf16, WS_WDN) + ((size_t)l * 65 + e) * 1024 * 256, nullptr, 256, 64 * kb, 32 * nb, nullptr, 1.f, scr, F.lane); continue; } r -= I4;
        if (r < I5) { const int l = r / 128, q = r % 128, kb = q / 32, nb = q % 32;
            cvt_item<0>(A.in[17] + (size_t)l * 256 * 1024, 1024, WSP(bf16, WS_WDN) + ((size_t)l * 65 + 64) * 1024 * 256, nullptr, 256, 64 * kb, 32 * nb, nullptr, 1.f, scr, F.lane); continue; } r -= I5;
        if (r < I6) { const int l = r / 36, q = r % 36, kb = q / 12, nb = q % 12;
            cvt_item<3>(A.in[5] + (size_t)l * 192 * 384, 384, WSP(bf16, WS_WUQ) + (size_t)l * 384 * 192, nullptr, 384, 64 * kb, 32 * nb, A.in[3] + l * 192, QSCALE96, scr, F.lane); continue; } r -= I6;
        if (r < I7) { const int l = r / 32, q = r % 32, kb = q / 16, nb = q % 16;
            cvt_item<3>(A.in[6] + (size_t)l * 128 * 512, 512, WSP(bf16, WS_WUKV) + (size_t)l * 512 * 128, nullptr, 512, 64 * kb, 32 * nb, A.in[4] + l * 128, 1.0f, scr, F.lane); continue; } r -= I7;
        { const int l = r / 32, q = r % 32, kb = q / 2, nb = q % 2;
            cvt_item<4>(A.in[12] + (size_t)l * 1024 * 64, 64, WSP(bf16, WS_WRH) + (size_t)l * 64 * 1024, WSP(bf16, WS_WRL) + (size_t)l * 64 * 1024, 1024, 64 * kb, 32 * nb, nullptr, 1.f, scr, F.lane); }
    }
    bf16* xb = WSP(bf16, WS_XB);
    for (int m = gw; m < NT; m += 2 * NGW) {
        const GAS f32x4* xr = (const GAS f32x4*)(A.in[0] + (size_t)m * DM) + F.lane; const GAS f32x4* xr2 = (const GAS f32x4*)(A.in[0] + (size_t)(m + NGW) * DM) + F.lane;
        GAS v2u* o8 = (GAS v2u*)(xb + (size_t)m * DM) + F.lane; GAS v2u* o82 = (GAS v2u*)(xb + (size_t)(m + NGW) * DM) + F.lane;
        f32x4 v[8];
#pragma unroll
        for (int j = 0; j < 4; ++j) { v[j] = xr[64 * j]; v[4 + j] = xr2[64 * j]; }
#pragma unroll
        for (int j = 0; j < 4; ++j) { v2u o; o.x = pk2(v[j].x, v[j].y); o.y = pk2(v[j].z, v[j].w); o8[64 * j] = o; v2u o2; o2.x = pk2(v[4 + j].x, v[4 + j].y); o2.y = pk2(v[4 + j].z, v[4 + j].w); o82[64 * j] = o2; }
    }
}
__device__ __forceinline__ int crow(int r, int hi) { return (r & 3) + 8 * (r >> 2) + 4 * hi; }
__device__ __forceinline__ unsigned tokey(float f) { unsigned u = __builtin_bit_cast(unsigned, f); if (u == 0x80000000u) u = 0u; return u ^ ((u >> 31) ? 0xffffffffu : 0x80000000u); }
__device__ __forceinline__ int half_sum(int v) {
    v += __builtin_amdgcn_update_dpp(0, v, 0xB1, 0xF, 0xF, true);
    v += __builtin_amdgcn_update_dpp(0, v, 0x4E, 0xF, 0xF, true);
    v += __builtin_amdgcn_update_dpp(0, v, 0x141, 0xF, 0xF, true);
    v += __builtin_amdgcn_update_dpp(0, v, 0x140, 0xF, 0xF, true);
    auto rr = __builtin_amdgcn_permlane16_swap((unsigned)v, (unsigned)v, false, false); const unsigned a_ = rr[0], b_ = rr[1];
    return (int)(a_ + b_);
}

constexpr int TK_LOWBIT = 12; constexpr unsigned TK_KEYMASK = ~((1u << TK_LOWBIT) - 1u);
struct TkPre { bf16x8 a0; f32x4 wq; };
__device__ __forceinline__ void topk_operands(Frame& F, int b, int c, int quarter, TkPre& P) {
    const int lane = lane_id_now(), g = lane >> 4, i16 = lane & 15, q0 = 64 * c + 16 * quarter + 2 * F.wave0; const size_t tokb = (size_t)b * SEQ;
    P.a0 = *(const bf16x8*)(WSP(bf16, WS_PROJ) + (tokb + q0 + (i16 >> 3)) * NPROJ + PC_IQ + (i16 & 7) * 32 + 8 * g);
    P.wq = *(const f32x4*)(WSP(float, WS_AUX) + (tokb + q0 + (g >> 1)) * 16 + 4 * (g & 1));
}
template <int NP>
__device__ __forceinline__ void topk_unit(Frame& F, int b, int c, int quarter, bool stage, bool havepre, int cnext, TkPre& io) {
    UNIT_BEGIN();
    const int lane = F.lane, w = F.wave, r32 = lane & 31, hi = lane >> 5, g = lane >> 4, i16 = lane & 15;
    const int np = 2 * (c + 1), q0 = 64 * c + 16 * quarter + 2 * w;
    const bf16* proj = WSP(bf16, WS_PROJ); const float* aux = WSP(float, WS_AUX); unsigned* mask32 = WSP(unsigned, WS_MASK);
    const size_t tokb = (size_t)b * SEQ;
    LAS unsigned char* kl = F.lds + 6144; constexpr int N16 = 512 * 64;
    if (stage) { const bf16* ik = WSP(bf16, WS_IK) + tokb * 32;
      for (int blk = w; blk < (np >> 1); blk += 8) { const int k0 = blk * 64;
#pragma unroll
          for (int ch = 0; ch < 4; ++ch)
              __builtin_amdgcn_global_load_lds((const unsigned*)(ik + (size_t)(k0 + lane) * 32 + ch * 8), (LAS unsigned*)(kl + ch * N16 + k0 * 16), 16, 0, 0); } }
    if (!havepre) topk_operands(F, b, c, quarter, io);
    const bf16x8 a0 = io.a0;
    const f32x4 wq = io.wq * 0.0625f;
    if (stage || !havepre) { VM_WAIT(); __syncthreads(); }
    unsigned key[NP];
    const LAS unsigned char* kp = kl + g * N16 + i16 * 16;
    int np_v = np; asm volatile("" : "+v"(np_v));
#define TK_RELU(x) __builtin_amdgcn_fmed3f((x), 0.f, __builtin_inff())
#define TK_SCORE(dA, dB, OUT) do { \
        float eA_ = TK_RELU(dA[0]) * wq[0]; asm volatile("" : "+v"(eA_)); eA_ = fmaf(TK_RELU(dA[1]), wq[1], eA_); asm volatile("" : "+v"(eA_)); eA_ = fmaf(TK_RELU(dA[2]), wq[2], eA_); asm volatile("" : "+v"(eA_)); eA_ = fmaf(TK_RELU(dA[3]), wq[3], eA_); asm volatile("" : "+v"(eA_)); \
        float eB_ = TK_RELU(dB[0]) * wq[0]; asm volatile("" : "+v"(eB_)); eB_ = fmaf(TK_RELU(dB[1]), wq[1], eB_); asm volatile("" : "+v"(eB_)); eB_ = fmaf(TK_RELU(dB[2]), wq[2], eB_); asm volatile("" : "+v"(eB_)); eB_ = fmaf(TK_RELU(dB[3]), wq[3], eB_); asm volatile("" : "+v"(eB_)); \
        auto rr_ = __builtin_amdgcn_permlane16_swap(__builtin_bit_cast(unsigned, eA_), __builtin_bit_cast(unsigned, eB_), false, false); const unsigned ra_ = rr_[0], rb_ = rr_[1]; \
        float sc_ = __uint_as_float(ra_) + __uint_as_float(rb_); asm volatile("" : "+v"(sc_)); OUT = sc_; } while (0)
#pragma unroll
    for (int p = 0; p < NP; p += 2) {
        const bf16x8 kA0 = *(const LAS bf16x8*)(kp + p * 512), kB0 = *(const LAS bf16x8*)(kp + p * 512 + 256), kA1 = *(const LAS bf16x8*)(kp + p * 512 + 512), kB1 = *(const LAS bf16x8*)(kp + p * 512 + 768);
        const f32x4 z4 = {0.f, 0.f, 0.f, 0.f};
        const f32x4 dA0 = __builtin_amdgcn_mfma_f32_16x16x32_bf16(a0, kA0, z4, 0, 0, 0), dB0 = __builtin_amdgcn_mfma_f32_16x16x32_bf16(a0, kB0, z4, 0, 0, 0);
        const f32x4 dA1 = __builtin_amdgcn_mfma_f32_16x16x32_bf16(a0, kA1, z4, 0, 0, 0), dB1 = __builtin_amdgcn_mfma_f32_16x16x32_bf16(a0, kB1, z4, 0, 0, 0);
        float s0, s1; TK_SCORE(dA0, dB0, s0); TK_SCORE(dA1, dB1, s1);
        key[p] = (p < np_v) ? (tokey(s0) & TK_KEYMASK) : 0u; key[p + 1] = (p + 1 < np_v) ? (tokey(s1) & TK_KEYMASK) : 0u;
        if ((p & 2) == 2) __builtin_amdgcn_sched_barrier(0);
    }
#undef TK_SCORE
#undef TK_RELU
    if (cnext >= 0) topk_operands(F, b, cnext, quarter, io);
    unsigned prefix = 0u; bool done = false;
    for (int bit = 31; bit >= TK_LOWBIT; --bit) {
        const unsigned cand = prefix | (1u << bit);
        int nn[4] = {0, 0, 0, 0};
#pragma unroll
        for (int p = 0; p < NP; ++p) nn[p & 3] += (key[p] >= cand) ? 1 : 0;
        int n = half_sum((nn[0] + nn[1]) + (nn[2] + nn[3]));
        if (!done) { if (n >= 256) prefix = cand; if (n == 256) done = true; }
        if (__all(done)) break;
    }
    LAS unsigned long long* wm = (LAS unsigned long long*)(F.lds + 1536 + w * 512);
    int cge = 0;
#pragma unroll
    for (int p = 0; p < NP; ++p) { const bool ge = key[p] >= prefix; cge += ge ? 1 : 0; wm[p] = __ballot(ge); if ((p & 7) == 7) __builtin_amdgcn_sched_barrier(0); }
    cge = half_sum(cge);
    if (!__all(cge == 256)) {
        int gtc = 0;
#pragma unroll
        for (int p = 0; p < NP; ++p) gtc += (key[p] > prefix) ? 1 : 0;
        gtc = half_sum(gtc);
        const int need = 256 - gtc; int run = 0; const unsigned below = (1u << r32) - 1u;
#pragma unroll
        for (int p = 0; p < NP; ++p) {
            const bool eq = key[p] == prefix, gt = key[p] > prefix;
            const unsigned long long be = __ballot(eq);
            const unsigned m32 = hi ? (unsigned)(be >> 32) : (unsigned)be;
            const int rank = __popc(m32 & below);
            const bool sel = gt || (eq && (run + rank < need));
            run += __popc(m32);
            wm[p] = __ballot(sel);
        }
    }
    LDS_WAIT();
    {
        const LAS unsigned* wm32 = (const LAS unsigned*)wm;
        if (lane < np) { mask32[(tokb + q0) * 64 + lane] = wm32[lane * 2]; mask32[(tokb + q0 + 1) * 64 + lane] = wm32[lane * 2 + 1]; }
    }
}

__device__ __forceinline__ void mla_stage(LAS unsigned char* lds, const bf16* W, int N, int K, int kchunk0, int nchunks, int w, int lane) {
    const int nb = N >> 6;
    for (int it = w; it < nchunks * nb; it += 8) { const int ch = it / nb, b64 = it % nb;
        __builtin_amdgcn_global_load_lds((const unsigned*)(W + ((size_t)(kchunk0 + ch) * N + b64 * 64 + lane) * 8), (LAS unsigned*)(lds + ch * (N * 16) + b64 * 1024), 16, 0, 0); }
}
template <int NC> __device__ __forceinline__ void mla_flush(LAS unsigned char* st, bf16* gdst  , int gpitch  , int lane_unused) {
    constexpr int PITCH = NC * 2 + 8, L8 = NC / 4, NJ = 32 * L8 / 64;
    (void)lane_unused;
    LDS_WAIT();
    const int lane = lane_id_now();
#pragma unroll
    for (int j0 = 0; j0 < NJ; j0 += 4) {
        v2u t[4];
#pragma unroll
        for (int j = 0; j < 4; ++j) { const int i = lane + 64 * (j0 + j), row = i / L8, pc = i % L8; t[j] = *(const LAS v2u*)(st + row * PITCH + pc * 8); }
#pragma unroll
        for (int j = 0; j < 4; ++j) { const int i = lane + 64 * (j0 + j), row = i / L8, pc = i % L8; const unsigned off = (unsigned)(row * gpitch + pc * 4); *(v2u*)(gdst + off) = t[j]; }
        __builtin_amdgcn_sched_barrier(0);
    }
    LDS_WAIT();
}
__device__ __forceinline__ void mla_unit(Frame& F, const Args& A, int layer, int unit) {
    UNIT_BEGIN();
    const int lane = F.lane, w = F.wave, r32 = lane & 31, hi = lane >> 5, rt = w & 3, nh = w >> 2;
    const int tok0 = unit * 128 + rt * 32, tok = tok0 + r32, pos = tok & (SEQ - 1);
    const bf16* proj = WSP(bf16, WS_PROJ); bf16* qm = WSP(bf16, WS_QMLA); bf16* km = WSP(bf16, WS_KMLA); bf16* vm = WSP(bf16, WS_VMLA);
    const bf16* wq = WSP(bf16, WS_WUQ) + (size_t)layer * 384 * 192; const bf16* wkv = WSP(bf16, WS_WUKV) + (size_t)layer * 512 * 128;
    const bf16* prow = proj + (size_t)tok * NPROJ;
    LAS unsigned char* lds = F.lds;
    LAS unsigned char* st = lds + w * 12800;
    __syncthreads();
    mla_stage(lds, wq, 384, 192, 0, 12, w, lane);
    float sq = 0.f, skv = 0.f;
    float cs[8], sn[8];
#pragma unroll
    for (int r = 0; r < 8; ++r) { const int i = crow(r, hi); const float inv = exp2f(-(float)i * (13.287712379549449f / 16.0f)); const float ang = (float)pos * inv;
        float rev = ang * 0.15915494309189535f; rev = rev - floorf(rev); sn[r] = __builtin_amdgcn_sinf(rev); cs[r] = __builtin_amdgcn_cosf(rev); }
    {
    bf16x8 bq[12];
#pragma unroll
    for (int kk = 0; kk < 12; ++kk) { bq[kk] = *(const bf16x8*)(prow + PC_CQ + 16 * kk + 8 * hi);
#pragma unroll
        for (int e = 0; e < 8; ++e) { const float v = bf2f((unsigned short)bq[kk][e]); sq += v * v; } }
    const float rq = rsqrtf(swap32_add(sq) * (1.0f / 192.0f) + RMS_EPS);
    f32x16 acc[6];
#pragma unroll
    for (int t = 0; t < 6; ++t) acc[t] = f32x16{};
#pragma unroll
    for (int stg = 0; stg < 2; ++stg) {
        VM_WAIT(); __syncthreads();
#pragma unroll
        for (int t = 0; t < 6; ++t) {
            const LAS unsigned char* wp = lds + hi * (384 * 16) + (32 * (6 * nh + t) + r32) * 16;
#pragma unroll
            for (int kk = 0; kk < 6; ++kk) { const bf16x8 a = *(const LAS bf16x8*)(wp + (2 * kk) * (384 * 16)); acc[t] = __builtin_amdgcn_mfma_f32_32x32x16_bf16(a, bq[6 * stg + kk], acc[t], 0, 0, 0); }
        }
        __syncthreads();
        if (stg == 0) mla_stage(lds, wq, 384, 192, 12, 12, w, lane);
    }
#ifdef MLA_PROBE_CUT
    if (A.rep && MLA_PROBE_CUT <= 1) { __syncthreads(); return; }
#endif
#pragma unroll
    for (int t = 0; t < 6; ++t) {
        float o[16];
#pragma unroll
        for (int r = 0; r < 16; ++r) o[r] = acc[t][r] * rq;
        if (t % 3 == 2) {
#pragma unroll
            for (int r = 0; r < 8; ++r) { const float x1 = o[r], x2 = o[r + 8]; o[r] = x1 * cs[r] - x2 * sn[r]; o[r + 8] = x2 * cs[r] + x1 * sn[r]; }
        }
#pragma unroll
        for (int g = 0; g < 4; ++g) { v2u w2; w2.x = cvt_pk_bf16(o[4 * g], o[4 * g + 1]); w2.y = cvt_pk_bf16(o[4 * g + 2], o[4 * g + 3]); *(LAS v2u*)(st + r32 * 392 + (32 * t + 8 * g + 4 * hi) * 2) = w2; }
    }
    mla_flush<192>(st, qm + (size_t)tok0 * 384 + 192 * nh, 384, lane);
    }
    __syncthreads();
#ifdef MLA_PROBE_CUT
    if (A.rep && MLA_PROBE_CUT <= 2) return;
#endif
    mla_stage(lds, wkv, 512, 128, 0, 16, w, lane);
    {
    float kr[16];
#pragma unroll
    for (int g = 0; g < 4; ++g) { const v2u w2 = *(const v2u*)(prow + PC_KR + 8 * g + 4 * hi); kr[4 * g] = bflo(w2.x); kr[4 * g + 1] = bfhi(w2.x); kr[4 * g + 2] = bflo(w2.y); kr[4 * g + 3] = bfhi(w2.y); }
    v2u krp[4];
    { float kro[16];
#pragma unroll
      for (int r = 0; r < 8; ++r) { kro[r] = kr[r] * cs[r] - kr[r + 8] * sn[r]; kro[r + 8] = kr[r + 8] * cs[r] + kr[r] * sn[r]; }
#pragma unroll
      for (int g = 0; g < 4; ++g) { krp[g].x = cvt_pk_bf16(kro[4 * g], kro[4 * g + 1]); krp[g].y = cvt_pk_bf16(kro[4 * g + 2], kro[4 * g + 3]); } }
    bf16x8 bkv[8];
#pragma unroll
    for (int kk = 0; kk < 8; ++kk) { bkv[kk] = *(const bf16x8*)(prow + PC_CKV + 16 * kk + 8 * hi);
#pragma unroll
        for (int e = 0; e < 8; ++e) { const float v = bf2f((unsigned short)bkv[kk][e]); skv += v * v; } }
    const float rkv = rsqrtf(swap32_add(skv) * (1.0f / 128.0f) + RMS_EPS);
    VM_WAIT(); __syncthreads();
    v2u res[2][4][4];
#pragma unroll
    for (int hh2 = 0; hh2 < 2; ++hh2) {
        const int hh = 2 * nh + hh2;
#pragma unroll
        for (int j = 0; j < 4; ++j) {
            f32x16 acc = {};
            const LAS unsigned char* wp = lds + hi * (512 * 16) + (32 * (4 * hh + j) + r32) * 16;
#pragma unroll
            for (int kk = 0; kk < 8; ++kk) { const bf16x8 a = *(const LAS bf16x8*)(wp + (2 * kk) * (512 * 16)); acc = __builtin_amdgcn_mfma_f32_32x32x16_bf16(a, bkv[kk], acc, 0, 0, 0); }
#pragma unroll
            for (int g = 0; g < 4; ++g) { res[hh2][j][g].x = cvt_pk_bf16(acc[4 * g] * rkv, acc[4 * g + 1] * rkv); res[hh2][j][g].y = cvt_pk_bf16(acc[4 * g + 2] * rkv, acc[4 * g + 3] * rkv); }
        }
        __builtin_amdgcn_sched_barrier(0);
    }
    __syncthreads();
#ifdef MLA_PROBE_CUT
    if (A.rep && MLA_PROBE_CUT <= 3) return;
#endif
#pragma unroll
    for (int hh2 = 0; hh2 < 2; ++hh2) {
#pragma unroll
        for (int j = 0; j < 2; ++j)
#pragma unroll
            for (int g = 0; g < 4; ++g) *(LAS v2u*)(st + r32 * 392 + (96 * hh2 + 32 * j + 8 * g + 4 * hi) * 2) = res[hh2][j][g];
#pragma unroll
        for (int g = 0; g < 4; ++g) *(LAS v2u*)(st + r32 * 392 + (96 * hh2 + 64 + 8 * g + 4 * hi) * 2) = krp[g];
    }
    mla_flush<192>(st, km + (size_t)tok0 * 384 + 192 * nh, 384, lane);
#pragma unroll
    for (int hh2 = 0; hh2 < 2; ++hh2)
#pragma unroll
        for (int j = 0; j < 2; ++j)
#pragma unroll
            for (int g = 0; g < 4; ++g) *(LAS v2u*)(st + r32 * 264 + (64 * hh2 + 32 * j + 8 * g + 4 * hi) * 2) = res[hh2][2 + j][g];
    mla_flush<128>(st, vm + (size_t)tok0 * 256 + 128 * nh, 256, lane);
    }
    __syncthreads();
}

__device__ __forceinline__ void cum_unit(Frame& F, const Args& A, int layer, int unit) {
    UNIT_BEGIN();
    const int b = unit >> 2, h = unit & 3, t = F.tid;
    const float* aux = WSP(float, WS_AUX); float* cum = WSP(float, WS_CUM);
    LAS float* wtot = (LAS float*)(F.lds);
    const float bf = A.in[2][layer * 4 + h];
    float v[4]; float run = 0.f;
#pragma unroll
    for (int i = 0; i < 4; ++i) { const float z = aux[((size_t)b * SEQ + 4 * t + i) * 16 + 8 + h] + bf; const float ls = fminf(z, 0.f) - log1pf(expf(-fabsf(z))); run += ls; v[i] = run; }
    float inc = 0.f;
#pragma unroll
    for (int j = 0; j < 64; ++j) { const float vj = __builtin_bit_cast(float, __builtin_amdgcn_readlane(__builtin_bit_cast(int, run), j)); inc += (j <= F.lane) ? vj : 0.f; }
    if (F.lane == 63) wtot[F.wave] = inc;
    __syncthreads();
    float base = inc - run;
    for (int w = 0; w < F.wave; ++w) base += wtot[w];
    f32x4 o4; o4.x = (base + v[0]) * LOG2E; o4.y = (base + v[1]) * LOG2E; o4.z = (base + v[2]) * LOG2E; o4.w = (base + v[3]) * LOG2E;
    *(f32x4*)(cum + ((size_t)(b * 4 + h)) * SEQ + 4 * t) = o4;
    __syncthreads();
}

__device__ __forceinline__ void knorm_jobs(Frame& F) {
    UNIT_BEGIN();
    float* kn = WSP(float, WS_KNORM);
    for (int job = F.vcu * 8 + F.wave; job < 64 * 32; job += F.G * 8) {
        const int bh = job >> 5, tile = job & 31, b = bh >> 2, h = bh & 3;
        const v4u* kp = (const v4u*)(WSP(bf16, WS_PROJ) + ((size_t)b * SEQ + 64 * tile + F.lane) * NPROJ + PC_FOX + 256 + h * 64);
        float ss = 0.f;
#pragma unroll
        for (int c = 0; c < 8; ++c) { const v4u v = kp[c];
#pragma unroll
            for (int j = 0; j < 4; ++j) { const unsigned w_ = v[j]; const float lo = __uint_as_float(w_ << 16), hi_ = __uint_as_float(w_ & 0xffff0000u); ss += lo * lo + hi_ * hi_; } }
        const float m = wave_max_nn(ss);
        if (F.lane == 0) kn[bh * 64 + tile] = sqrtf(m) * 1.002f;
    }
}
constexpr int AT_K = 0, AT_V = 36864, AT_TAB = 61440, AT_WS = 63488, AT_MASK = 65536, AT_CUM = 65536, AT_END = AT_MASK + 256 * 264;
static_assert(AT_END <= MISC_OFF, "attention LDS");
typedef short v4i16_t __attribute__((ext_vector_type(4)));

template <int KIND>
__device__ __forceinline__ void attn_unit(Frame& F, const Args& A, int layer, int b, int h, int qb) {
    UNIT_BEGIN();
    constexpr int DQK = (KIND == 2) ? 96 : 64, NKC = DQK / 8, NKS = DQK / 16;
    constexpr int OFF = (KIND == 1) ? 128 : 256, NTAB = OFF + 64, TPAD = 128;
    const int tid = F.tid, lane = F.lane, wid = F.wave, r32 = lane & 31, hi = lane >> 5;
    LAS unsigned char* lds = F.lds;
    const bf16* proj = WSP(bf16, WS_PROJ);
    const size_t tokb = (size_t)b * SEQ;
    const bf16 *Qg, *Kg, *Vg; int PQ, PK, PV;
    if (KIND == 2) { Qg = WSP(bf16, WS_QMLA) + tokb * 384 + h * 96; Kg = WSP(bf16, WS_KMLA) + tokb * 384 + h * 96; Vg = WSP(bf16, WS_VMLA) + tokb * 256 + h * 64; PQ = 384; PK = 384; PV = 256; }
    else { const int base = (KIND == 0) ? PC_FOX : (KIND == 1) ? PC_DSA : PC_BAND; Qg = proj + tokb * NPROJ + base + h * 64; Kg = Qg + 256; Vg = Qg + 512; PQ = NPROJ; PK = NPROJ; PV = NPROJ; }
    const int mixcol = ((KIND == 0) ? 0 : (KIND == 1) ? 256 : (KIND == 2) ? 512 : 768) + h * 64;
    int t_lo = (KIND == 3) ? ((4 * qb - 8) > 0 ? (4 * qb - 8) : 0) : 0; const int t_hi = 4 * qb + 4;
    const int cw = 4 * qb + (wid >> 1), rsub = 32 * (wid & 1) + r32;
    LAS float* tab = (LAS float*)(lds + AT_TAB); LAS float* ctab = (LAS float*)(lds + AT_CUM); LAS float* wsf = (LAS float*)(lds + AT_WS) + wid * 64;
    float farc = 0.f;
    if (KIND == 1) {
        farc = A.in[7][15 * 4 + h] * LOG2E;
        if (tid < NTAB) { const int rel = tid - OFF, n = rel < 0 ? -rel : rel; int bk; if (n < 8) bk = n; else { bk = 8 + (31 - __clz(n * n)) - 6; bk = bk > 15 ? 15 : bk; } if (rel > 0) bk += 16; tab[TPAD + tid] = A.in[7][bk * 4 + h] * LOG2E; }
        else if (tid < NTAB + TPAD) tab[tid - NTAB] = farc;
        if (qb >= 1) { const v2u* gm = WSP(v2u, WS_MASK) + (tokb + 256 * qb) * 32; LAS v2u* lm = (LAS v2u*)(lds + AT_MASK);
            for (int idx = tid; idx < 256 * 32; idx += 512) { const int row = idx >> 5, T = idx & 31; if (T < t_hi) lm[row * 33 + T] = gm[(size_t)row * 32 + T]; } }
    }
    if (KIND == 3) {
        const float* cr = A.in[8] + (size_t)(layer * 4 + h) * 513;
        farc = cr[512] * LOG2E;
        if (tid < NTAB) { int d = OFF - tid; d = d < -256 ? -256 : (d > 256 ? 256 : d); tab[TPAD + tid] = cr[d + 256] * LOG2E; }
        else if (tid < NTAB + TPAD) tab[tid - NTAB] = farc;
    }
    bf16x8 qr[NKS];
    if (KIND == 0) {
        const float* cu = WSP(float, WS_CUM) + (size_t)(b * 4 + h) * SEQ; const float cref = cu[256 * qb];
        for (int s = tid; s < 256 * qb + 256; s += 512) ctab[s] = cref - cu[s];
        { const bf16* qp = Qg + (size_t)(64 * cw + rsub) * PQ + 8 * hi;
#pragma unroll
          for (int d0 = 0; d0 < NKS; ++d0) qr[d0] = *(const bf16x8*)(qp + 16 * d0); }
        float ss = 0.f;
#pragma unroll
        for (int d0 = 0; d0 < NKS; ++d0) { const v4u qw = __builtin_bit_cast(v4u, qr[d0]);
#pragma unroll
            for (int j = 0; j < 4; ++j) { const unsigned w_ = qw[j]; const float lo = __uint_as_float(w_ << 16), hi_ = __uint_as_float(w_ & 0xffff0000u); ss += lo * lo + hi_ * hi_; } }
        ss = wave_max_nn(swap32_add(ss));
        if (lane == 0) tab[wid] = ss;
        __syncthreads();
        float qm = 0.f;
#pragma unroll
        for (int w = 0; w < 8; ++w) qm = fmaxf(qm, tab[w]);
        qm = sqrtf(qm) * 1.002f;
        const float* kn = WSP(float, WS_KNORM) + (size_t)(b * 4 + h) * 64;
        const float kd = fmaxf(fmaxf(kn[4 * qb], kn[4 * qb + 1]), fmaxf(kn[4 * qb + 2], kn[4 * qb + 3]));
        const float thr = -(qm * kd) - 40.f;
        int tl = 0;
        while (tl < 4 * qb && qm * kn[32 + tl] + ctab[64 * tl + 63] <= thr) ++tl;
        t_lo = __builtin_amdgcn_readfirstlane(tl);
    }
    const bf16* ksrc = Kg + (size_t)lane * PK; const bf16* vsrc = Vg + (size_t)(16 * (wid & 3) + (lane >> 2)) * PV + (wid >> 2) * 32 + (lane & 3) * 8;
#define AT_ISSUE(t, slot) do { \
        _Pragma("unroll") for (int c_ = 0; c_ < 2; ++c_) { const int cc_ = wid + 8 * c_; if (cc_ < NKC) \
            __builtin_amdgcn_global_load_lds((const unsigned*)(ksrc + (size_t)(t) * 64 * PK + cc_ * 8), (LAS unsigned*)(lds + AT_K + (slot) * 12288 + cc_ * 1024), 16, 0, 0); } \
        __builtin_amdgcn_global_load_lds((const unsigned*)(vsrc + (size_t)(t) * 64 * PV), (LAS unsigned*)(lds + AT_V + (slot) * 8192 + wid * 1024), 16, 0, 0); } while (0)
    AT_ISSUE(t_lo, 0);
    if (t_lo + 1 < t_hi) AT_ISSUE(t_lo + 1, 1);
    if (KIND != 0) { const bf16* qp = Qg + (size_t)(64 * cw + rsub) * PQ + 8 * hi;
#pragma unroll
      for (int d0 = 0; d0 < NKS; ++d0) qr[d0] = *(const bf16x8*)(qp + 16 * d0); }
    float m_run = -INFINITY, l_run = 0.f; f32x16 o[2]; o[0] = f32x16{}; o[1] = f32x16{};
    const bool three = (NKC > 8) && (wid + 8 < NKC);
    { const bf16x8 q0_ = qr[0]; asm volatile("" :: "v"(q0_)); }
    if (t_lo + 1 < t_hi) { if (three) asm volatile("s_waitcnt vmcnt(3)" ::: "memory"); else asm volatile("s_waitcnt vmcnt(2)" ::: "memory"); } else VM_WAIT();
    __syncthreads();
    const int vrd0 = ((lane >> 4) & 1) * 32 + (lane & 3) * 8 + (4 * hi + ((lane & 15) >> 2)) * 64;
    int slot = 0;
    for (int t = t_lo; t < t_hi; ++t) {
        if (t + 2 < t_hi) { const int s2 = slot >= 1 ? slot - 1 : 2; AT_ISSUE(t + 2, s2); }
        const bool active = (KIND == 3) ? (t >= cw - 8 && t <= cw) : (t <= cw);
        if (active) {
            const LAS unsigned char* Ks = lds + AT_K + slot * 12288; const LAS unsigned char* Vs = lds + AT_V + slot * 8192;
            f32x16 p0, p1;
            if (KIND == 0) {
#pragma unroll
                for (int g = 0; g < 4; ++g) { const f32x4 a = *(const LAS f32x4*)(ctab + 64 * t + 8 * g + 4 * hi), c = *(const LAS f32x4*)(ctab + 64 * t + 32 + 8 * g + 4 * hi);
                    p0[4 * g] = a.x; p0[4 * g + 1] = a.y; p0[4 * g + 2] = a.z; p0[4 * g + 3] = a.w; p1[4 * g] = c.x; p1[4 * g + 1] = c.y; p1[4 * g + 2] = c.z; p1[4 * g + 3] = c.w; }
            } else { p0 = f32x16{}; p1 = f32x16{}; }
#pragma unroll
            for (int d0 = 0; d0 < NKS; ++d0) { const bf16x8 k0 = *(const LAS bf16x8*)(Ks + (2 * d0 + hi) * 1024 + r32 * 16), k1 = *(const LAS bf16x8*)(Ks + (2 * d0 + hi) * 1024 + r32 * 16 + 512);
                p0 = __builtin_amdgcn_mfma_f32_32x32x16_bf16(k0, qr[d0], p0, 0, 0, 0); p1 = __builtin_amdgcn_mfma_f32_32x32x16_bf16(k1, qr[d0], p1, 0, 0, 0); }
            if (KIND == 1 || KIND == 3) {
                const int maxrel = 64 * (t - cw) + 63 - 32 * (wid & 1);
                if (maxrel <= -OFF) {
                    p0 = p0 + farc; p1 = p1 + farc;
                } else {
                    const LAS float* tb = tab + (TPAD + 64 * (t - cw) - rsub + OFF + 4 * hi);
#pragma unroll
                    for (int r = 0; r < 16; ++r) { p0[r] += tb[(r & 3) + 8 * (r >> 2)]; p1[r] += tb[32 + (r & 3) + 8 * (r >> 2)]; }
                }
            }
            if (KIND == 1) {
                if (qb >= 1) { const v2u mw = ((const LAS v2u*)(lds + AT_MASK))[(64 * (wid >> 1) + rsub) * 33 + t]; const unsigned wl = mw.x >> (4 * hi), wh = mw.y >> (4 * hi);
#pragma unroll
                    for (int r = 0; r < 16; ++r) { const int bit = (r & 3) + 8 * (r >> 2);
                        const unsigned m0_ = (unsigned)__builtin_amdgcn_sbfe((int)wl, bit, 1), m1_ = (unsigned)__builtin_amdgcn_sbfe((int)wh, bit, 1);
                        p0[r] = __uint_as_float((__float_as_uint(p0[r]) & m0_) | (~m0_ & 0xff800000u)); p1[r] = __uint_as_float((__float_as_uint(p1[r]) & m1_) | (~m1_ & 0xff800000u)); } }
            }
            if (KIND == 0) {
                if (t == cw) {
#pragma unroll
                    for (int r = 0; r < 16; ++r) { const int kv = crow(r, hi); if (kv > rsub) p0[r] = -INFINITY; if (kv + 32 > rsub) p1[r] = -INFINITY; } }
            }
            float rm;
            { const f32x16 mx = __builtin_elementwise_max(p0, p1);
              float a_ = fmaxf(fmaxf(mx[0], mx[1]), mx[2]), b_ = fmaxf(fmaxf(mx[3], mx[4]), mx[5]), c_ = fmaxf(fmaxf(mx[6], mx[7]), mx[8]), d_ = fmaxf(fmaxf(mx[9], mx[10]), mx[11]);
              a_ = fmaxf(fmaxf(a_, mx[12]), mx[13]); b_ = fmaxf(fmaxf(b_, mx[14]), mx[15]); rm = fmaxf(fmaxf(a_, b_), fmaxf(c_, d_)); }
            rm = swap32_max(rm);
            const float mnew = fmaxf(m_run, rm), muse = (mnew == -INFINITY) ? 0.f : mnew;
            const float alpha = __builtin_amdgcn_exp2f(m_run - muse);
            p0 = p0 - muse; p1 = p1 - muse;
#pragma unroll
            for (int r = 0; r < 16; ++r) { p0[r] = __builtin_amdgcn_exp2f(p0[r]); p1[r] = __builtin_amdgcn_exp2f(p1[r]); }
            float ps;
            { const f32x16 sv = p0 + p1; const f32x4 s4 = (f32x4){sv[0], sv[1], sv[2], sv[3]} + (f32x4){sv[4], sv[5], sv[6], sv[7]} + (f32x4){sv[8], sv[9], sv[10], sv[11]} + (f32x4){sv[12], sv[13], sv[14], sv[15]}; ps = (s4[0] + s4[1]) + (s4[2] + s4[3]); }
            l_run = l_run * alpha + ps; m_run = mnew;
            if (__any(alpha != 1.0f)) {
                if (hi == 0) wsf[r32] = alpha;
                LDS_WAIT();
                f32x16 av;
#pragma unroll
                for (int g = 0; g < 4; ++g) { const f32x4 a = *(const LAS f32x4*)(wsf + 8 * g + 4 * hi); av[4 * g] = a.x; av[4 * g + 1] = a.y; av[4 * g + 2] = a.z; av[4 * g + 3] = a.w; }
                o[0] = o[0] * av; o[1] = o[1] * av;
            }
            v4u pw[4];
#pragma unroll
            for (int i = 0; i < 4; ++i) { pw[0][i] = cvt_pk_bf16(p0[2 * i], p0[2 * i + 1]); pw[1][i] = cvt_pk_bf16(p0[8 + 2 * i], p0[9 + 2 * i]); pw[2][i] = cvt_pk_bf16(p1[2 * i], p1[2 * i + 1]); pw[3][i] = cvt_pk_bf16(p1[8 + 2 * i], p1[9 + 2 * i]); }
#pragma unroll
            for (int d0 = 0; d0 < 2; ++d0)
#pragma unroll
                for (int ks = 0; ks < 4; ++ks) {
                    const LAS unsigned char* vp = Vs + vrd0 + d0 * 4096 + ks * 1024;
                    const s16x4 vlo = __builtin_bit_cast(s16x4, __builtin_amdgcn_ds_read_tr16_b64_v4i16((LAS v4i16_t*)vp));
                    const s16x4 vhi = __builtin_bit_cast(s16x4, __builtin_amdgcn_ds_read_tr16_b64_v4i16((LAS v4i16_t*)(vp + 512)));
                    const bf16x8 vf = (bf16x8){vlo[0], vlo[1], vlo[2], vlo[3], vhi[0], vhi[1], vhi[2], vhi[3]};
                    o[d0] = __builtin_amdgcn_mfma_f32_32x32x16_bf16(__builtin_bit_cast(bf16x8, pw[ks]), vf, o[d0], 0, 0, 0);
                }
        }
        if (t + 2 < t_hi) { if (three) asm volatile("s_waitcnt vmcnt(3)" ::: "memory"); else asm volatile("s_waitcnt vmcnt(2)" ::: "memory"); } else VM_WAIT();
        asm volatile("s_waitcnt lgkmcnt(0)" ::: "memory"); __builtin_amdgcn_s_barrier(); asm volatile("" ::: "memory");
        slot = (slot == 2) ? 0 : slot + 1;
    }
#undef AT_ISSUE
    const float ltot = swap32_add(l_run);
    if (hi == 0) wsf[r32] = 1.0f / ltot;
    LDS_WAIT();
    float rli[16];
#pragma unroll
    for (int g = 0; g < 4; ++g) { const f32x4 a = *(const LAS f32x4*)(wsf + 8 * g + 4 * hi); rli[4 * g] = a.x; rli[4 * g + 1] = a.y; rli[4 * g + 2] = a.z; rli[4 * g + 3] = a.w; }
    LAS bf16* stg = (LAS bf16*)(lds + wid * 4096);
#pragma unroll
    for (int r = 0; r < 16; ++r) { const int orow = crow(r, hi);
#pragma unroll
        for (int d0 = 0; d0 < 2; ++d0) stg[orow * 64 + d0 * 32 + r32] = (bf16)f2bf(o[d0][r] * rli[r]); }
    LDS_WAIT();
    bf16* Ow = WSP(bf16, WS_MIXED) + (tokb + 64 * cw + 32 * (wid & 1)) * DM + mixcol;
#pragma unroll
    for (int i = 0; i < 4; ++i) { const int row = i * 8 + (lane >> 3), ch = lane & 7; const v4u v = *(const LAS v4u*)(stg + row * 64 + ch * 8); *(v4u*)(Ow + (size_t)row * DM + ch * 8) = v; }
    LDS_WAIT(); __syncthreads();
}

__device__ __forceinline__ int queue_next(Frame& F, int qi) {
    if (F.tid == 0) F.MISC[16] = __hip_atomic_fetch_add((unsigned*)(F.ctl + CW_Q + 64 * qi), 1u, __ATOMIC_RELAXED, __HIP_MEMORY_SCOPE_AGENT);
    __syncthreads();
    const int v = (int)F.MISC[16];
    __syncthreads();
    return v;
}
#define A6_SBAR() __builtin_amdgcn_sched_barrier(0)
#define A6_PIN(x) asm volatile("" : "+v"(x))
#define A6_WAIT_BAR(N) asm volatile("s_waitcnt vmcnt(" #N ") lgkmcnt(0)\n\ts_barrier" ::: "memory")
#define A6_MFMA(a, b, c) __builtin_amdgcn_mfma_f32_32x32x16_bf16(a, b, c, 0, 0, 0)
typedef const LAS unsigned char* a6_lptr;
__device__ __forceinline__ void a6_glds16(const void* g, unsigned lds_base) {
    unsigned sv; asm volatile("s_mov_b32 %0, m0\n\ts_mov_b32 m0, %2\n\ts_nop 0\n\tglobal_load_lds_dwordx4 %1, off\n\ts_mov_b32 m0, %0" : "=&s"(sv) : "v"(g), "s"(lds_base) : "memory"); }
__device__ __forceinline__ void a6_kload2(bf16x8* kf, a6_lptr kp, int j) { kf[2 * j] = *(const LAS bf16x8*)(kp + j * 2048); kf[2 * j + 1] = *(const LAS bf16x8*)(kp + j * 2048 + 512); }
__device__ __forceinline__ s16x4 a6_vtr(a6_lptr p) { return __builtin_bit_cast(s16x4, __builtin_amdgcn_ds_read_tr16_b64_v4i16((LAS v4i16_t*)p)); }
#define A6_MX3(a, b, c) __builtin_fmaxf(__builtin_fmaxf((a), (b)), (c))
__device__ __forceinline__ float a6_rowmax(const f32x16& p0, const f32x16& p1) {
    float a = A6_MX3(p0[0], p0[1], p1[0]), b = A6_MX3(p0[2], p0[3], p1[1]); a = A6_MX3(a, p1[2], p1[3]);
#pragma unroll
    for (int r = 4; r < 16; r += 4) { a = A6_MX3(a, p0[r], p0[r + 1]); b = A6_MX3(b, p0[r + 2], p0[r + 3]); a = A6_MX3(a, p1[r], p1[r + 1]); b = A6_MX3(b, p1[r + 2], p1[r + 3]); }
    float m = __builtin_fmaxf(a, b);
    auto rr = __builtin_amdgcn_permlane32_swap(__float_as_uint(m), __float_as_uint(m), false, false); const unsigned x_ = rr[0], y_ = rr[1];
    return __builtin_fmaxf(__uint_as_float(x_), __uint_as_float(y_)); }
__device__ __forceinline__ void a6_cmask(f32x16& p0, f32x16& p1, int jb, int qrel, int hi) {
    const int kb = 64 * jb + 4 * hi;
#pragma unroll
    for (int r = 0; r < 16; ++r) { const int kv = kb + (r & 3) + 8 * (r >> 2); if (kv > qrel) p0[r] = -INFINITY; if (kv + 32 > qrel) p1[r] = -INFINITY; } }

template <int KIND>
__device__ __forceinline__ void attn64_unit(Frame& F, const Args& A, int layer, int b, int h, int qb) {
    UNIT_BEGIN();
    constexpr int OFF = (KIND == 1) ? 128 : 256, NTAB = OFF + 64, TPAD = 128, TINF = TPAD + NTAB, SLOTB = 8192;
    constexpr int NKS = (KIND == 2) ? 6 : 4, KSL = (KIND == 2) ? 12288 : 8704;
    constexpr float THR = 8.0f;
    const int tid = F.tid, lane = F.lane, wid = F.wave, r32 = lane & 31, hi = lane >> 5;
    LAS unsigned char* lds = F.lds; const unsigned lds0 = (unsigned)(unsigned long)lds;
    const bf16* proj = WSP(bf16, WS_PROJ);
    const size_t tokb = (size_t)b * SEQ;
    const bf16 *Qg, *Kg, *Vg; int PQ, PK, PV;
    if (KIND == 2) { Qg = WSP(bf16, WS_QMLA) + tokb * 384 + h * 96; Kg = WSP(bf16, WS_KMLA) + tokb * 384 + h * 96; Vg = WSP(bf16, WS_VMLA) + tokb * 256 + h * 64; PQ = 384; PK = 384; PV = 256; }
    else { const int base = (KIND == 0) ? PC_FOX : (KIND == 1) ? PC_DSA : PC_BAND; Qg = proj + tokb * NPROJ + base + h * 64; Kg = Qg + 256; Vg = Qg + 512; PQ = NPROJ; PK = NPROJ; PV = NPROJ; }
    const int mixcol = ((KIND == 0) ? 0 : (KIND == 1) ? 256 : (KIND == 2) ? 512 : 768) + h * 64;
    int t_lo = (KIND == 3) ? ((4 * qb - 8) > 0 ? (4 * qb - 8) : 0) : 0; const int t_hi = 4 * qb + 4;
    const int cw = 4 * qb + (wid >> 1), rsub = 32 * (wid & 1) + r32, qrel = 32 * wid + r32;
    LAS float* tab = (LAS float*)(lds + AT_TAB); LAS float* ctab = (LAS float*)(lds + AT_CUM); LAS float* wsf = (LAS float*)(lds + AT_WS) + wid * 64;
    bf16x8 qr[NKS];
    { const bf16* qp = Qg + (size_t)(64 * cw + rsub) * PQ + 8 * hi;
#pragma unroll
      for (int d0 = 0; d0 < NKS; ++d0) qr[d0] = *(const bf16x8*)(qp + 16 * d0); }
    if (KIND == 0) {
        const float* cu = WSP(float, WS_CUM) + (size_t)(b * 4 + h) * SEQ; const float cref = cu[256 * qb];
        const float* kn = WSP(float, WS_KNORM) + (size_t)(b * 4 + h) * 64;
        { const int n_ = 256 * qb + 256; float cv[4]; const float knv = kn[lane];
#pragma unroll
          for (int i = 0; i < 4; ++i) { const int s_ = tid + 512 * i; cv[i] = cu[s_ < n_ ? s_ : n_ - 1]; }
#pragma unroll
          for (int i = 0; i < 4; ++i) { const int s_ = tid + 512 * i; if (s_ < n_) ctab[s_] = cref - cv[i]; }
          if (wid == 0) tab[16 + lane] = knv; }
        float ss = 0.f;
#pragma unroll
        for (int d0 = 0; d0 < 4; ++d0) { const v4u qw = __builtin_bit_cast(v4u, qr[d0]);
#pragma unroll
            for (int j = 0; j < 4; ++j) { const unsigned w_ = qw[j]; const float lo = __uint_as_float(w_ << 16), hi_ = __uint_as_float(w_ & 0xffff0000u); ss += lo * lo + hi_ * hi_; } }
        ss = wave_max_nn(swap32_add(ss));
        if (lane == 0) tab[wid] = ss;
        __syncthreads();
        float qm = 0.f;
#pragma unroll
        for (int w = 0; w < 8; ++w) qm = fmaxf(qm, tab[w]);
        qm = sqrtf(qm) * 1.002f;
        const float kd = fmaxf(fmaxf(tab[16 + 4 * qb], tab[16 + 4 * qb + 1]), fmaxf(tab[16 + 4 * qb + 2], tab[16 + 4 * qb + 3]));
        const float thr = -(qm * kd) - 40.f;
        int tl = 0; float krun = 0.f;
        while (tl < 4 * qb) { krun = fmaxf(krun, tab[16 + tl]); if (qm * krun + ctab[64 * tl + 63] <= thr) ++tl; else break; }
        t_lo = __builtin_amdgcn_readfirstlane(tl) & ~1;
    }
    const int NT = t_hi - t_lo;
    const int krow_ = 8 * wid + (lane >> 3);
    const bf16* ksrc = (KIND == 2) ? (Kg + (size_t)(64 * t_lo + lane) * PK + wid * 8) : (Kg + (size_t)(64 * t_lo + krow_) * PK + (((lane & 7) ^ (krow_ & 7)) * 8));
    const bf16* ksrc2 = Kg + (size_t)(64 * t_lo + lane) * PK + (8 + (wid & 3)) * 8;
    const bf16* vsrc = Vg + (size_t)(64 * t_lo + 16 * (wid & 3) + (lane >> 2)) * PV + (wid >> 2) * 32 + (lane & 3) * 8;
    const unsigned kdst = lds0 + AT_K + wid * ((KIND == 2) ? 1024 : 1088), kdst2 = lds0 + AT_K + (8 + (wid & 3)) * 1024, vdst = lds0 + AT_V + wid * 1024;
#define DMA_K(t, slot) do { a6_glds16(ksrc + (size_t)(t) * 64 * PK, (unsigned)__builtin_amdgcn_readfirstlane(kdst + (slot))); \
        if (KIND == 2) a6_glds16(ksrc2 + (size_t)(t) * 64 * PK, (unsigned)__builtin_amdgcn_readfirstlane(kdst2 + (slot))); } while (0)
#define DMA_V(t, slot) a6_glds16(vsrc + (size_t)(t) * 64 * PV, (unsigned)__builtin_amdgcn_readfirstlane(vdst + (slot)))
    const a6_lptr kp0 = lds + AT_K + hi * 1024 + r32 * 16;
    int ka[4];
#pragma unroll
    for (int d0 = 0; d0 < 4; ++d0) ka[d0] = AT_K + (r32 >> 3) * 1088 + (r32 & 7) * 128 + (((2 * d0 + hi) ^ (r32 & 7)) * 16);
    const a6_lptr vp0 = lds + AT_V + ((lane >> 4) & 1) * 32 + (lane & 3) * 8 + (4 * hi + ((lane & 15) >> 2)) * 64;
    DMA_K(0, 0); DMA_V(0, 0); DMA_K(1, KSL); DMA_K(2, 2 * KSL);
    if (KIND == 1) {
        const float farc = A.in[7][15 * 4 + h] * LOG2E;
        if (tid < NTAB) { const int rel = tid - OFF, n = rel < 0 ? -rel : rel; int bk; if (n < 8) bk = n; else { bk = 8 + (31 - __clz(n * n)) - 6; bk = bk > 15 ? 15 : bk; } if (rel > 0) bk += 16; tab[TPAD + tid] = A.in[7][bk * 4 + h] * LOG2E; }
        else if (tid < NTAB + TPAD) tab[tid - NTAB] = farc;
        else if (tid < NTAB + TPAD + 64) tab[tid] = -INFINITY;
        if (qb >= 1) { const v2u* gm = WSP(v2u, WS_MASK) + (tokb + 256 * qb) * 32 + tid; LAS v2u* lm = (LAS v2u*)(lds + AT_MASK) + (tid >> 5) * 33 + (tid & 31);
            v2u mv[16];
#pragma unroll
            for (int i = 0; i < 16; ++i) mv[i] = gm[i * 512];
#pragma unroll
            for (int i = 0; i < 16; ++i) lm[i * 16 * 33] = mv[i]; }
    }
    if (KIND == 3) {
        const float* cr = A.in[8] + (size_t)(layer * 4 + h) * 513;
        const float farc = cr[512] * LOG2E;
        if (tid < NTAB) { int d = OFF - tid; d = d < -256 ? -256 : (d > 256 ? 256 : d); tab[TPAD + tid] = cr[d + 256] * LOG2E; }
        else if (tid < NTAB + TPAD) tab[tid - NTAB] = farc;
        else tab[tid] = -INFINITY;
    }
    float mhat = 0.f, l_reg = 0.f; f32x16 o[2]; o[0] = f32x16{}; o[1] = f32x16{};
    bool resc = false;
    f32x16 pA0, pA1, pB0, pB1; bf16x8 kf[2 * NKS]; s16x4 vlo[8], vhi[8]; v4u pw0, pw1, pw2, pw3;
    f32x4 cbA, cbB; unsigned wl = ~0u, wh = ~0u;
    int sl_prev = 0, sl_cur = 0, sl_next = SLOTB, sk_cur = 0, sk_next = KSL; bool visn = true; float nmv = 0.f;
#define ROT() do { sl_prev = sl_cur; sl_cur = sl_next; sl_next = (sl_next == 2 * SLOTB) ? 0 : sl_next + SLOTB; sk_cur = sk_next; sk_next = (sk_next == 2 * KSL) ? 0 : sk_next + KSL; } while (0)
#define WAITB_STEADY() do { if (KIND == 2) { A6_WAIT_BAR(3); } else { A6_WAIT_BAR(2); } } while (0)
    a6_lptr cptr = lds;
#define CSET(tn) do { const int T_ = t_lo + (tn); \
        if (KIND == 0) cptr = (a6_lptr)(ctab + 64 * T_ + 4 * hi); \
        else if (KIND == 2) visn = (T_ <= cw); \
        else { int ix_ = TPAD + 64 * (T_ - cw) - rsub + OFF + 4 * hi; ix_ = ix_ < 0 ? 0 : ix_; \
               const bool vis_ = (KIND == 1) ? (T_ <= cw) : (T_ <= cw && T_ >= cw - 8); ix_ = vis_ ? ix_ : TINF; cptr = (a6_lptr)(tab + ix_); \
               if (KIND == 1) { if (qb >= 1) { const v2u mw_ = ((const LAS v2u*)(lds + AT_MASK))[(64 * (wid >> 1) + rsub) * 33 + T_]; wl = mw_.x >> (4 * hi); wh = mw_.y >> (4 * hi); } } } } while (0)
#define CLD(half, g) ((KIND == 0) ? *(const LAS f32x4*)(cptr + 4 * (32 * (half) + 8 * (g))) \
        : (f32x4){((const LAS float*)cptr)[32 * (half) + 8 * (g)], ((const LAS float*)cptr)[32 * (half) + 8 * (g) + 1], ((const LAS float*)cptr)[32 * (half) + 8 * (g) + 2], ((const LAS float*)cptr)[32 * (half) + 8 * (g) + 3]})
#define CAP1(X, half, g, j, cv) do { float v_ = (KIND == 2) ? nmv : ((cv) - mhat); \
        if (KIND == 1) { const unsigned m_ = (unsigned)__builtin_amdgcn_sbfe((int)((half) ? wh : wl), (j) + 8 * (g), 1); v_ = __uint_as_float(__builtin_amdgcn_bitop3_b32(__float_as_uint(v_), m_, 0xff800000u, 0xE2)); }     \
        X[4 * (g) + (j)] = v_; } while (0)
#define CAP(X, half, g, CB) do { CAP1(X, half, g, 0, CB.x); CAP1(X, half, g, 1, CB.y); CAP1(X, half, g, 2, CB.z); CAP1(X, half, g, 3, CB.w); } while (0)
#define CALL(X0, X1) do { nmv = visn ? -mhat : -INFINITY; _Pragma("unroll") for (int g_ = 0; g_ < 4; ++g_) { f32x4 c0_ = f32x4{}, c1_ = f32x4{}; if (KIND != 2) { c0_ = CLD(0, g_); c1_ = CLD(1, g_); } CAP(X0, 0, g_, c0_); CAP(X1, 1, g_, c1_); } } while (0)
#define RESC() do { if (resc) { LDS_WAIT(); _Pragma("unroll") for (int g_ = 0; g_ < 4; ++g_) { const f32x4 a_ = *(const LAS f32x4*)(wsf + 8 * g_ + 4 * hi); \
        _Pragma("unroll") for (int d_ = 0; d_ < 2; ++d_) { o[d_][4 * g_] *= a_.x; o[d_][4 * g_ + 1] *= a_.y; o[d_][4 * g_ + 2] *= a_.z; o[d_][4 * g_ + 3] *= a_.w; } } } } while (0)
#define DECIDE(C0, C1) do { const float rm_ = a6_rowmax(C0, C1); resc = false; \
        if (__builtin_expect(__any(rm_ > THR), 0)) { const float dl_ = fmaxf(rm_, 0.f); mhat += dl_; \
            _Pragma("unroll") for (int r = 0; r < 16; ++r) { C0[r] -= dl_; C1[r] -= dl_; } \
            const float f_ = __builtin_amdgcn_exp2f(-dl_); l_reg *= f_; if (hi == 0) wsf[r32] = f_; resc = true; } } while (0)
    if (KIND == 2) { A6_WAIT_BAR(5); } else { A6_WAIT_BAR(3); }
    CSET(0); CALL(pA0, pA1);
    _Pragma("unroll") for (int d0 = 0; d0 < NKS; ++d0) { if (KIND == 2) a6_kload2(kf, kp0, d0); else { kf[2 * d0] = *(const LAS bf16x8*)(lds + ka[d0 & 3]); kf[2 * d0 + 1] = *(const LAS bf16x8*)(lds + ka[d0 & 3] + 4352); } }
    _Pragma("unroll") for (int d0 = 0; d0 < NKS; ++d0) { pA0 = A6_MFMA(kf[2 * d0], qr[d0], pA0); pA1 = A6_MFMA(kf[2 * d0 + 1], qr[d0], pA1); }
    if (KIND == 0) { if (NT == 4) a6_cmask(pA0, pA1, 0, qrel, hi); }
    DECIDE(pA0, pA1);
#pragma unroll
    for (int r = 0; r < 16; ++r) { pA0[r] = __builtin_amdgcn_exp2f(pA0[r]); pA1[r] = __builtin_amdgcn_exp2f(pA1[r]); }
    CSET(1); CALL(pB0, pB1);
    A6_WAIT_BAR(0);
    DMA_K(3, 0); DMA_V(1, SLOTB); ROT();
    _Pragma("unroll") for (int d0 = 0; d0 < NKS; ++d0) { if (KIND == 2) a6_kload2(kf, kp0 + sk_cur, d0); else { kf[2 * d0] = *(const LAS bf16x8*)(lds + sk_cur + ka[d0 & 3]); kf[2 * d0 + 1] = *(const LAS bf16x8*)(lds + sk_cur + ka[d0 & 3] + 4352); } }
    WAITB_STEADY();
#define PKW(P, i) cvt_pk_bf16(P[i], P[(i) + 1])
#define PAF(k) __builtin_bit_cast(bf16x8, pw##k)
#define VFR(i) (bf16x8){vlo[i][0], vlo[i][1], vlo[i][2], vlo[i][3], vhi[i][0], vhi[i][1], vhi[i][2], vhi[i][3]}
#define VRD(i) do { vlo[i] = a6_vtr(vp_ + (((i) >> 2) * 4096 + ((i) & 3) * 1024)); vhi[i] = a6_vtr(vp_ + (((i) >> 2) * 4096 + ((i) & 3) * 1024 + 512)); } while (0)
#define KRD(G, j) do { if (G) { if (KIND == 2) a6_kload2(kf, kp0 + sk_next, j); else { kf[2 * (j)] = *(const LAS bf16x8*)(lds + sk_next + ka[(j) & 3]); kf[2 * (j) + 1] = *(const LAS bf16x8*)(lds + sk_next + ka[(j) & 3] + 4352); } A6_SBAR(); } } while (0)
#define GAPA(MF, a0, a1, a2, a3, W0, W1, PW) do { MF; sacc += a0; sacc += a1; sacc += a2; sacc += a3; A6_PIN(sacc); W0; W1; A6_PIN(PW); A6_SBAR(); } while (0)
#define GAPB(MF, X, B, GL, PX, half, g, CUR, NXT, nh, ng, LDN) do { if ((KIND != 2) && (GL) && (LDN)) NXT = CLD(nh, ng); MF; \
        X[B] = __builtin_amdgcn_exp2f(X[B]); X[(B) + 1] = __builtin_amdgcn_exp2f(X[(B) + 1]); X[(B) + 2] = __builtin_amdgcn_exp2f(X[(B) + 2]); X[(B) + 3] = __builtin_amdgcn_exp2f(X[(B) + 3]); A6_PIN(X); \
        if (GL) { CAP(PX, half, g, CUR); A6_PIN(PX); } A6_SBAR(); } while (0)
#define STEP(C0, C1, P0, P1, t, MASK, GK, GV, GL) do { A6_SBAR(); \
    const a6_lptr vp_ = vp0 + sl_prev; \
    VRD(0); A6_SBAR(); float sacc = P0[0] + P0[1]; \
                       GAPA(C0 = A6_MFMA(kf[0], qr[0], C0), P0[2], P0[3], P0[4], P0[5],     pw0[0] = PKW(P0, 0),  pw0[1] = PKW(P0, 2),  pw0); \
    VRD(4); A6_SBAR(); GAPA(C1 = A6_MFMA(kf[1], qr[0], C1), P0[6], P0[7], P0[8], P0[9],     pw0[2] = PKW(P0, 4),  pw0[3] = PKW(P0, 6),  pw0); \
    VRD(1); A6_SBAR(); GAPA(C0 = A6_MFMA(kf[2], qr[1], C0), P0[10], P0[11], P0[12], P0[13], pw1[0] = PKW(P0, 8),  pw1[1] = PKW(P0, 10), pw1); \
    VRD(5); A6_SBAR(); GAPA(C1 = A6_MFMA(kf[3], qr[1], C1), P0[14], P0[15], P1[0], P1[1],   pw1[2] = PKW(P0, 12), pw1[3] = PKW(P0, 14), pw1); \
    VRD(2); A6_SBAR(); GAPA(C0 = A6_MFMA(kf[4], qr[2], C0), P1[2], P1[3], P1[4], P1[5],     pw2[0] = PKW(P1, 0),  pw2[1] = PKW(P1, 2),  pw2); \
    VRD(6); A6_SBAR(); GAPA(C1 = A6_MFMA(kf[5], qr[2], C1), P1[6], P1[7], P1[8], P1[9],     pw2[2] = PKW(P1, 4),  pw2[3] = PKW(P1, 6),  pw2); \
    VRD(3); A6_SBAR(); GAPA(C0 = A6_MFMA(kf[6], qr[3], C0), P1[10], P1[11], P1[12], P1[13], pw3[0] = PKW(P1, 8),  pw3[1] = PKW(P1, 10), pw3); \
    VRD(7); A6_SBAR(); GAPA(C1 = A6_MFMA(kf[7], qr[3], C1), P1[14], P1[15], 0.f, 0.f,       pw3[2] = PKW(P1, 12), pw3[3] = PKW(P1, 14), pw3); \
    if (KIND == 2) { C0 = A6_MFMA(kf[2 * NKS - 4], qr[NKS - 2], C0); C1 = A6_MFMA(kf[2 * NKS - 3], qr[NKS - 2], C1); C0 = A6_MFMA(kf[2 * NKS - 2], qr[NKS - 1], C0); C1 = A6_MFMA(kf[2 * NKS - 1], qr[NKS - 1], C1); A6_SBAR(); } \
    l_reg += sacc; \
    if (GK) DMA_K((t) + 3, sk_cur); if (GV) DMA_V((t) + 1, sl_next); \
    if (GL) { CSET((t) + 1); if (KIND != 2) cbA = CLD(0, 0); } \
    if ((KIND == 0) && (MASK)) { const int jb_ = (t) - (NT - 4); if (jb_ >= 0) a6_cmask(C0, C1, jb_, qrel, hi); } \
    DECIDE(C0, C1); nmv = visn ? -mhat : -INFINITY; \
    A6_SBAR(); \
                GAPB(o[0] = A6_MFMA(PAF(0), VFR(0), o[0]), C0, 0,  GL, P0, 0, 0, cbA, cbB, 0, 1, true); \
                GAPB(o[1] = A6_MFMA(PAF(0), VFR(4), o[1]), C0, 4,  GL, P0, 0, 1, cbB, cbA, 0, 2, true); \
    KRD(GL, 0); GAPB(o[0] = A6_MFMA(PAF(1), VFR(1), o[0]), C0, 8,  GL, P0, 0, 2, cbA, cbB, 0, 3, true); \
    KRD(GL, 1); GAPB(o[1] = A6_MFMA(PAF(1), VFR(5), o[1]), C0, 12, GL, P0, 0, 3, cbB, cbA, 1, 0, true); \
    KRD(GL, 2); GAPB(o[0] = A6_MFMA(PAF(2), VFR(2), o[0]), C1, 0,  GL, P1, 1, 0, cbA, cbB, 1, 1, true); \
    KRD(GL, 3); GAPB(o[1] = A6_MFMA(PAF(2), VFR(6), o[1]), C1, 4,  GL, P1, 1, 1, cbB, cbA, 1, 2, true); \
    if (KIND == 2) KRD(GL, NKS - 2); \
                GAPB(o[0] = A6_MFMA(PAF(3), VFR(3), o[0]), C1, 8,  GL, P1, 1, 2, cbA, cbB, 1, 3, true); \
    if (KIND == 2) KRD(GL, NKS - 1); \
                GAPB(o[1] = A6_MFMA(PAF(3), VFR(7), o[1]), C1, 12, GL, P1, 1, 3, cbB, cbA, 0, 0, false); \
    } while (0)
    int t = 1;
    for (; t + 5 < NT; t += 2) {
        STEP(pB0, pB1, pA0, pA1, t, false, true, true, true);     WAITB_STEADY(); RESC(); ROT();
        STEP(pA0, pA1, pB0, pB1, t + 1, false, true, true, true); WAITB_STEADY(); RESC(); ROT();
    }
#define ENDW(tt) do { if ((tt) + 3 < NT) { WAITB_STEADY(); } else if ((tt) + 2 < NT) { A6_WAIT_BAR(1); } else { A6_WAIT_BAR(0); } } while (0)
    for (; t + 1 < NT; t += 2) {
        STEP(pB0, pB1, pA0, pA1, t, true, (t + 3 < NT), true, true);         ENDW(t);     RESC(); ROT();
        STEP(pA0, pA1, pB0, pB1, t + 1, true, (t + 4 < NT), true, true);     ENDW(t + 1); RESC(); ROT();
    }
    STEP(pB0, pB1, pA0, pA1, NT - 1, true, false, false, false); RESC();
    { float sacc = pB0[0] + pB0[1];
#pragma unroll
      for (int r = 2; r < 16; ++r) sacc += pB0[r];
#pragma unroll
      for (int r = 0; r < 16; ++r) sacc += pB1[r];
      l_reg += sacc;
      pw0 = (v4u){PKW(pB0, 0), PKW(pB0, 2), PKW(pB0, 4), PKW(pB0, 6)}; pw1 = (v4u){PKW(pB0, 8), PKW(pB0, 10), PKW(pB0, 12), PKW(pB0, 14)};
      pw2 = (v4u){PKW(pB1, 0), PKW(pB1, 2), PKW(pB1, 4), PKW(pB1, 6)}; pw3 = (v4u){PKW(pB1, 8), PKW(pB1, 10), PKW(pB1, 12), PKW(pB1, 14)};
      const a6_lptr vp_ = vp0 + sl_cur;
#pragma unroll
      for (int i = 0; i < 8; ++i) VRD(i);
      o[0] = A6_MFMA(PAF(0), VFR(0), o[0]); o[1] = A6_MFMA(PAF(0), VFR(4), o[1]); o[0] = A6_MFMA(PAF(1), VFR(1), o[0]); o[1] = A6_MFMA(PAF(1), VFR(5), o[1]);
      o[0] = A6_MFMA(PAF(2), VFR(2), o[0]); o[1] = A6_MFMA(PAF(2), VFR(6), o[1]); o[0] = A6_MFMA(PAF(3), VFR(3), o[0]); o[1] = A6_MFMA(PAF(3), VFR(7), o[1]); }
#undef DMA_K
#undef DMA_V
#undef ROT
#undef CSET
#undef CLD
#undef CAP1
#undef CAP
#undef CALL
#undef RESC
#undef DECIDE
#undef PKW
#undef PAF
#undef VFR
#undef VRD
#undef KRD
#undef GAPA
#undef GAPB
#undef STEP
#undef ENDW
#undef WAITB_STEADY
    const float ltot = swap32_add(l_reg);
    if (hi == 0) wsf[r32] = 1.0f / ltot;
    LDS_WAIT();
    float rli[16];
#pragma unroll
    for (int g = 0; g < 4; ++g) { const f32x4 a = *(const LAS f32x4*)(wsf + 8 * g + 4 * hi); rli[4 * g] = a.x; rli[4 * g + 1] = a.y; rli[4 * g + 2] = a.z; rli[4 * g + 3] = a.w; }
    LAS bf16* stg = (LAS bf16*)(lds + wid * 4096);
#pragma unroll
    for (int r = 0; r < 16; ++r) { const int orow = crow(r, hi);
#pragma unroll
        for (int d0 = 0; d0 < 2; ++d0) stg[orow * 64 + d0 * 32 + r32] = (bf16)cvt_pk_bf16(o[d0][r] * rli[r], 0.f); }
    LDS_WAIT();
    bf16* Ow = WSP(bf16, WS_MIXED) + (tokb + 64 * cw + 32 * (wid & 1)) * DM + mixcol;
#pragma unroll
    for (int i = 0; i < 4; ++i) { const int row = i * 8 + (lane >> 3), ch = lane & 7; const v4u v = *(const LAS v4u*)(stg + row * 64 + ch * 8); *(v4u*)(Ow + (size_t)row * DM + ch * 8) = v; }
    asm volatile("s_waitcnt lgkmcnt(0)\n\ts_barrier" ::: "memory");
}
__device__ __forceinline__ void unpack8(const v4u w, float* v) { v[0] = bflo(w.x); v[1] = bfhi(w.x); v[2] = bflo(w.y); v[3] = bfhi(w.y); v[4] = bflo(w.z); v[5] = bfhi(w.z); v[6] = bflo(w.w); v[7] = bfhi(w.w); }
__device__ __forceinline__ void ln16(float* v, const float* g, const float* bb) {
    float s = 0.f;
#pragma unroll
    for (int i = 0; i < 16; ++i) s += v[i];
    const float mean = wave_sum(s) * (1.0f / DM); float q = 0.f;
#pragma unroll
    for (int i = 0; i < 16; ++i) { v[i] -= mean; q += v[i] * v[i]; }
    const float rstd = rsqrtf(wave_sum(q) * (1.0f / DM) + LN_EPS);
#pragma unroll
    for (int i = 0; i < 16; ++i) v[i] = v[i] * rstd * g[i] + bb[i];
}
__device__ __forceinline__ void load_gb(const float* gp, const float* bp, int lane, float* g, float* bb) {
#pragma unroll
    for (int hf = 0; hf < 2; ++hf)
#pragma unroll
        for (int q = 0; q < 2; ++q) { const f32x4 a = *(const f32x4*)(gp + 512 * hf + 8 * lane + 4 * q), c = *(const f32x4*)(bp + 512 * hf + 8 * lane + 4 * q);
            g[8 * hf + 4 * q] = a.x; g[8 * hf + 4 * q + 1] = a.y; g[8 * hf + 4 * q + 2] = a.z; g[8 * hf + 4 * q + 3] = a.w;
            bb[8 * hf + 4 * q] = c.x; bb[8 * hf + 4 * q + 1] = c.y; bb[8 * hf + 4 * q + 2] = c.z; bb[8 * hf + 4 * q + 3] = c.w; }
}
__device__ __forceinline__ v4u pack8(const float* v) { v4u w; w.x = cvt_pk_bf16(v[0], v[1]); w.y = cvt_pk_bf16(v[2], v[3]); w.z = cvt_pk_bf16(v[4], v[5]); w.w = cvt_pk_bf16(v[6], v[7]); return w; }

__device__ __forceinline__ void ln1_router_unit(Frame& F, const Args& A, int layer, int unit) {
    UNIT_BEGIN();
    const int lane = F.lane, wid = F.wave, tid = F.tid, r32 = lane & 31, hi = lane >> 5;
    const bool dry = A.rep != 0;
    const bf16* y1 = WSP(bf16, WS_Y1); bf16* xb = dry ? WSP(bf16, WS_MIXED) : WSP(bf16, WS_XB);
    LAS float* lg = (LAS float*)(F.lds);
    LAS int* hist = (LAS int*)(F.lds + 33280);
    LAS int* basee = (LAS int*)(F.lds + 33536);
    LAS int* ek = (LAS int*)(F.lds + 33792);
    LAS float* gk = (LAS float*)(F.lds + 37888);
    const int tok0 = unit * 128;
    {
        float g[16], bb[16]; load_gb(A.in[10] + layer * DM, A.in[11] + layer * DM, lane, g, bb);
        for (int i4 = 0; i4 < 16; i4 += 8) {
            v4u ld[8][2];
#pragma unroll
            for (int q = 0; q < 8; ++q) { const size_t row = (size_t)(tok0 + wid * 16 + i4 + q) * DM; ld[q][0] = *(const v4u*)(y1 + row + 8 * lane); ld[q][1] = *(const v4u*)(y1 + row + 512 + 8 * lane); }
#pragma unroll
            for (int q = 0; q < 8; ++q) { const size_t row = (size_t)(tok0 + wid * 16 + i4 + q) * DM;
                float v[16]; unpack8(ld[q][0], v); unpack8(ld[q][1], v + 8);
                ln16(v, g, bb);
                *(v4u*)(xb + row + 8 * lane) = pack8(v); *(v4u*)(xb + row + 512 + 8 * lane) = pack8(v + 8); }
        }
    }
#ifdef P5_PROBE_CUT
    if (dry && P5_PROBE_CUT <= 1) { VM_WAIT(); __syncthreads(); return; }
#endif
    VM_WAIT(); __syncthreads();
    {
        const int rt = wid & 3, ct = wid >> 2;
        const unsigned lds0 = (unsigned)(unsigned long)F.lds;
        const char* xg = (const char*)xb + (size_t)tok0 * 2048; const char* hg = (const char*)(WSP(bf16, WS_WRH) + (size_t)layer * 64 * 1024); const char* lgw = (const char*)(WSP(bf16, WS_WRL) + (size_t)layer * 64 * 1024);
        const int lrow = lane >> 4, lp = lane & 15;
#define R_ISSUE(c, bo) do { \
            _Pragma("unroll") for (int i_ = 0; i_ < 4; ++i_) { const int q_ = 4 * wid + i_, row_ = 4 * q_ + lrow; \
                a6_glds16(xg + (size_t)row_ * 2048 + (c) * 256 + ((lp ^ (row_ & 15)) * 16), (unsigned)__builtin_amdgcn_readfirstlane(lds0 + (bo) + q_ * 1024)); } \
            _Pragma("unroll") for (int i_ = 0; i_ < 2; ++i_) { const int q_ = 2 * wid + i_, row_ = 4 * q_ + lrow; \
                a6_glds16(hg + (size_t)row_ * 2048 + (c) * 256 + ((lp ^ (row_ & 15)) * 16), (unsigned)__builtin_amdgcn_readfirstlane(lds0 + (bo) + 32768 + q_ * 1024)); \
                a6_glds16(lgw + (size_t)row_ * 2048 + (c) * 256 + ((lp ^ (row_ & 15)) * 16), (unsigned)__builtin_amdgcn_readfirstlane(lds0 + (bo) + 49152 + q_ * 1024)); } } while (0)
        R_ISSUE(0, 0); R_ISSUE(1, 65536);
        f32x16 acc = {};
        const int arow = 32 * rt + r32, brow = 32 * ct + r32;
        for (int c = 0; c < 8; ++c) {
            if (c + 1 < 8) { A6_WAIT_BAR(8); } else { A6_WAIT_BAR(0); }
            const LAS unsigned char* bp = F.lds + (c & 1) * 65536;
#pragma unroll
            for (int s_ = 0; s_ < 8; ++s_) { const int P = 2 * s_ + hi;
                const bf16x8 a = *(const LAS bf16x8*)(bp + arow * 256 + ((P ^ (arow & 15)) * 16));
                const bf16x8 b1 = *(const LAS bf16x8*)(bp + 32768 + brow * 256 + ((P ^ (brow & 15)) * 16)), b2 = *(const LAS bf16x8*)(bp + 49152 + brow * 256 + ((P ^ (brow & 15)) * 16));
                acc = __builtin_amdgcn_mfma_f32_32x32x16_bf16(a, b1, acc, 0, 0, 0); acc = __builtin_amdgcn_mfma_f32_32x32x16_bf16(a, b2, acc, 0, 0, 0); }
            if (c + 2 < 8) { asm volatile("s_waitcnt lgkmcnt(0)\n\ts_barrier" ::: "memory"); R_ISSUE(c + 2, (c & 1) * 65536); }
        }
#undef R_ISSUE
        asm volatile("s_waitcnt lgkmcnt(0)\n\ts_barrier" ::: "memory");
#pragma unroll
        for (int r = 0; r < 16; ++r) lg[(32 * rt + crow(r, hi)) * 65 + 32 * ct + r32] = acc[r];
        if (tid < 64) hist[tid] = 0;
    }
    __syncthreads();
#ifdef P5_PROBE_CUT
    if (dry && P5_PROBE_CUT <= 2) return;
#endif
    {
        const int tk = tid >> 2, sub = tid & 3;
        const float* rb = A.in[13] + layer * 64 + 16 * sub;
        float v[16];
#pragma unroll
        for (int j = 0; j < 16; ++j) { const float z = lg[tk * 65 + 16 * sub + j]; v[j] = __builtin_amdgcn_rcpf(1.0f + __builtin_amdgcn_exp2f(-z * LOG2E)) + rb[j]; }
        unsigned taken = 0u; int se[8]; float ssum = 0.f; float ss[8];
#pragma unroll
        for (int k = 0; k < 8; ++k) {
            float best = -INFINITY; int bi = 0;
#pragma unroll
            for (int j = 0; j < 16; ++j) { const bool ok = !((taken >> j) & 1u) && (v[j] > best); best = ok ? v[j] : best; bi = ok ? j : bi; }
            int gi = 16 * sub + bi;
#pragma unroll
            for (int st = 0; st < 2; ++st) {
                const float ob = __builtin_bit_cast(float, st ? __builtin_amdgcn_update_dpp(0, __builtin_bit_cast(int, best), 0x4E, 0xF, 0xF, true) : __builtin_amdgcn_update_dpp(0, __builtin_bit_cast(int, best), 0xB1, 0xF, 0xF, true));
                const int og = st ? __builtin_amdgcn_update_dpp(0, gi, 0x4E, 0xF, 0xF, true) : __builtin_amdgcn_update_dpp(0, gi, 0xB1, 0xF, 0xF, true);
                const bool take = (ob > best) || (ob == best && og < gi);
                best = take ? ob : best; gi = take ? og : gi;
            }
            if ((gi >> 4) == sub) taken |= 1u << (gi & 15);
            se[k] = gi;
            const float z = lg[tk * 65 + gi]; ss[k] = __builtin_amdgcn_rcpf(1.0f + __builtin_amdgcn_exp2f(-z * LOG2E)); ssum += ss[k];
        }
        const float sc = 2.5f / ssum;
#pragma unroll
        for (int k = 0; k < 8; ++k) if ((k >> 1) == sub) { const int pos = atomicAdd((int*)&hist[se[k]], 1); ek[tk * 8 + k] = se[k] | (pos << 8); gk[tk * 8 + k] = ss[k] * sc; }
    }
    __syncthreads();
#ifdef P5_PROBE_CUT
    if (dry && P5_PROBE_CUT <= 3) return;
#endif
    if (tid < 64) basee[tid] = (int)__hip_atomic_fetch_add((unsigned*)(F.ctl + CW_CNT + 64 * layer + tid + (dry ? 4096 : 0)), (unsigned)hist[tid], __ATOMIC_RELAXED, __HIP_MEMORY_SCOPE_AGENT);
    __syncthreads();
    {
        int* list = dry ? WSP(int, WS_QMLA) : WSP(int, WS_LIST); float* gate = dry ? WSP(float, WS_VMLA) : WSP(float, WS_GATE); unsigned* sref = dry ? WSP(unsigned, WS_KMLA) : WSP(unsigned, WS_SREF);
        for (int i = tid; i < 1024; i += 512) { const int w = ek[i], e = w & 255, pos = w >> 8; const int rid = (tok0 + (i >> 3)) * 8 + (i & 7);
            const int slot = basee[e] + pos; if (slot < NT) list[(size_t)e * NT + slot] = rid; gate[rid] = gk[i]; sref[rid] = ((unsigned)e << 16) | (unsigned)slot; }
    }
    __syncthreads();
}

__device__ __forceinline__ void reduce_ln2_rows(Frame& F, const Args& A, int layer, bool last) {
    const int lane = F.lane; const int gw = F.vcu * 8 + F.wave, NGW = F.G * 8;
    bf16* xb = WSP(bf16, WS_XB); const bf16* yb = WSP(bf16, WS_YBUF); const bool dry = A.rep != 0; bf16* xo = dry ? WSP(bf16, WS_Y1) : xb;
    const unsigned* sref = WSP(unsigned, WS_SREF); const float* gates = WSP(float, WS_GATE);
    LAS unsigned* pre256 = (LAS unsigned*)(F.lds);
    {   unsigned cnt_lane = __hip_atomic_load((const unsigned*)(F.ctl + CW_CNT + 64 * layer) + lane, __ATOMIC_RELAXED, __HIP_MEMORY_SCOPE_AGENT);
        if (cnt_lane > (unsigned)NT) cnt_lane = NT;
        const unsigned nt_ = (cnt_lane + 255u) >> 8; unsigned pre = 0u, tot = 0u;
#pragma unroll
        for (int j = 0; j < 64; ++j) { const unsigned v = (unsigned)__builtin_amdgcn_readlane((int)nt_, j); pre += (j < lane) ? v : 0u; tot += v; }
        pre256[lane] = 256u * pre; if (lane == 0) pre256[64] = 256u * tot;
        __syncthreads();
    }
    const unsigned shbase = pre256[64];
#if YFP8
    float g[16], bb[16]; load_gb(A.in[18] + layer * DM, A.in[19] + layer * DM, lane, g, bb);
    const unsigned char* yb8 = (const unsigned char*)yb;
    for (int m0 = gw; m0 < NT; m0 += 2 * NGW) {
        v4u lx[2][2]; v2u ly[2][9][2]; f32x4 gq[2][2];
#pragma unroll
        for (int q = 0; q < 2; ++q) { const int m = m0 + q * NGW; const size_t row = (size_t)m * DM;
            lx[q][0] = *(const v4u*)(xb + row + 8 * lane); lx[q][1] = *(const v4u*)(xb + row + 512 + 8 * lane);
            const v4u s0 = *(const v4u*)(sref + (size_t)m * 8), s1 = *(const v4u*)(sref + (size_t)m * 8 + 4);
            gq[q][0] = *(const f32x4*)(gates + (size_t)m * 8); gq[q][1] = *(const f32x4*)(gates + (size_t)m * 8 + 4);
#pragma unroll
            for (int k = 0; k < 9; ++k) { const unsigned sr = (k < 4) ? s0[k & 3] : s1[k & 3];
                const size_t yr = (k < 8) ? (size_t)(pre256[(sr >> 16) & 63] + (sr & 0xffffu)) * DM : (size_t)(shbase + (unsigned)m) * DM;
                ly[q][k][0] = *(const v2u*)(yb8 + yr + 8 * lane); ly[q][k][1] = *(const v2u*)(yb8 + yr + 512 + 8 * lane); } }
#pragma unroll
        for (int q = 0; q < 2; ++q) { const int m = m0 + q * NGW; const size_t row = (size_t)m * DM;
            float v[16]; unpack8(lx[q][0], v); unpack8(lx[q][1], v + 8);
            float ys[16];
#pragma unroll
            for (int i = 0; i < 16; ++i) ys[i] = 0.f;
#pragma unroll
            for (int k = 0; k < 9; ++k) { const float gk_ = (k < 4) ? gq[q][0][k & 3] : (k < 8) ? gq[q][1][k & 3] : 1.0f;
#pragma unroll
                for (int hf = 0; hf < 2; ++hf)
#pragma unroll
                    for (int d = 0; d < 2; ++d) { const int wd = (int)ly[q][k][hf][d]; const auto lo = __builtin_amdgcn_cvt_pk_f32_fp8(wd, false); const auto hi2 = __builtin_amdgcn_cvt_pk_f32_fp8(wd, true);
                        ys[8 * hf + 4 * d] = fmaf(gk_, lo[0], ys[8 * hf + 4 * d]); ys[8 * hf + 4 * d + 1] = fmaf(gk_, lo[1], ys[8 * hf + 4 * d + 1]);
                        ys[8 * hf + 4 * d + 2] = fmaf(gk_, hi2[0], ys[8 * hf + 4 * d + 2]); ys[8 * hf + 4 * d + 3] = fmaf(gk_, hi2[1], ys[8 * hf + 4 * d + 3]); } }
#pragma unroll
            for (int i = 0; i < 16; ++i) v[i] = v[i] * ALPHA + ys[i] * YINV;
            ln16(v, g, bb);
            *(v4u*)(xo + row + 8 * lane) = pack8(v); *(v4u*)(xo + row + 512 + 8 * lane) = pack8(v + 8);
            if (last && !dry) { float* op = A.out + row;
                *(f32x4*)(op + 8 * lane) = (f32x4){v[0], v[1], v[2], v[3]}; *(f32x4*)(op + 8 * lane + 4) = (f32x4){v[4], v[5], v[6], v[7]};
                *(f32x4*)(op + 512 + 8 * lane) = (f32x4){v[8], v[9], v[10], v[11]}; *(f32x4*)(op + 512 + 8 * lane + 4) = (f32x4){v[12], v[13], v[14], v[15]}; } }
    }
}
#else
    float g[16], bb[16]; load_gb(A.in[18] + layer * DM, A.in[19] + layer * DM, lane, g, bb);
    for (int m0 = gw; m0 < NT; m0 += 2 * NGW) {
        v4u ld[2][20];
#pragma unroll
        for (int q = 0; q < 2; ++q) { const int m = m0 + q * NGW; const size_t row = (size_t)m * DM;
            ld[q][0] = *(const v4u*)(xb + row + 8 * lane); ld[q][1] = *(const v4u*)(xb + row + 512 + 8 * lane);
            const v4u s0 = *(const v4u*)(sref + (size_t)m * 8), s1 = *(const v4u*)(sref + (size_t)m * 8 + 4);
#pragma unroll
            for (int k = 0; k < 9; ++k) { const unsigned sr = (k < 4) ? s0[k & 3] : s1[k & 3];
                const size_t yr = (k < 8) ? (size_t)(pre256[(sr >> 16) & 63] + (sr & 0xffffu)) * DM : (size_t)(shbase + (unsigned)m) * DM;
                ld[q][2 + 2 * k] = *(const v4u*)(yb + yr + 8 * lane); ld[q][3 + 2 * k] = *(const v4u*)(yb + yr + 512 + 8 * lane); } }
#pragma unroll
        for (int q = 0; q < 2; ++q) { const int m = m0 + q * NGW; const size_t row = (size_t)m * DM;
            float v[16]; unpack8(ld[q][0], v); unpack8(ld[q][1], v + 8);
#pragma unroll
            for (int i = 0; i < 16; ++i) v[i] *= ALPHA;
#pragma unroll
            for (int k = 0; k < 9; ++k) { float t[16]; unpack8(ld[q][2 + 2 * k], t); unpack8(ld[q][3 + 2 * k], t + 8);
#pragma unroll
                for (int i = 0; i < 16; ++i) v[i] += t[i]; }
            ln16(v, g, bb);
            *(v4u*)(xo + row + 8 * lane) = pack8(v); *(v4u*)(xo + row + 512 + 8 * lane) = pack8(v + 8);
            if (last && !dry) { float* op = A.out + row;
                *(f32x4*)(op + 8 * lane) = (f32x4){v[0], v[1], v[2], v[3]}; *(f32x4*)(op + 8 * lane + 4) = (f32x4){v[4], v[5], v[6], v[7]};
                *(f32x4*)(op + 512 + 8 * lane) = (f32x4){v[8], v[9], v[10], v[11]}; *(f32x4*)(op + 512 + 8 * lane + 4) = (f32x4){v[12], v[13], v[14], v[15]}; } }
    }
}
#endif
#ifndef MK_MULTI
#define MK_MULTI 0
#endif
constexpr int NPH = 1 + 8 * DEPTH;
#ifndef PHMASK
#define PHMASK 0x1FF
#endif
#define PHON(i) ((PHMASK >> (i)) & 1)
#ifndef P7_PROBE_NOSTORE
#define P7_PROBE_NOSTORE 0
#endif
#ifndef P7_ALIGN
#define P7_ALIGN true
#endif
#ifndef P3REP_SEL
#define P3REP_SEL 15
#endif
#ifndef P2REP_SEL
#define P2REP_SEL 7
#endif

__global__ void __launch_bounds__(512, 2) mk_fwd(Args args) {
    extern __shared__ __attribute__((aligned(16))) unsigned char lds[];
    Frame F;
    F.lds = (LAS unsigned char*)lds; F.MISC = (volatile LAS unsigned*)(F.lds + MISC_OFF);
    F.tid = threadIdx.x; F.lane = F.tid & 63; F.wave = __builtin_amdgcn_readfirstlane(F.tid >> 6); F.wave0 = F.wave;
    F.G = gridDim.x; { const int bx = blockIdx.x; F.vcu = (F.G % 8 == 0) ? (bx % 8) * (F.G / 8) + bx / 8 : bx; }
    F.G0 = F.G; F.vcu0 = F.vcu; F.ws = (GAS unsigned char*)args.ws; F.ws0 = (GAS unsigned char*)args.ws; F.ctl = (gu32*)(args.ws + WS_CTL);
    for (int u = F.tid; u < 64; u += 512) ((LAS unsigned*)(F.lds + MISC_OFF))[u] = 0u;
    __syncthreads();
    const int lo = args.ph_lo, hi = args.ph_hi;
    XcdBarrier bar; bar.bar = (unsigned*)(F.ctl + CW_BAR); bar.x = 0; bar.st = nullptr;
    if (hi - lo > 1) bar = xcd_barrier_post((unsigned*)(F.ctl + CW_BAR), F.MISC + 8, F.tid == 0);
#define IN(k) (lo <= (k) && (k) < hi)
#define BOTH(k) (IN(k) && IN((k) + 1))
#define GRID_BAR() do { const bool ld_ = (F.wave0 == 0) && (lane_id_now() == 0); xcd_barrier(bar, ld_); } while (0)
#define PHASE_BEGIN() do { F.lane = lane_id_now(); F.wave = F.wave0; F.tid = F.wave0 * 64 + F.lane; { GAS unsigned char* w_ = F.ws0; asm volatile("" : "+s"(w_)); F.ws = w_; int g_ = F.G0, v_ = F.vcu0; asm volatile("" : "+s"(g_), "+s"(v_)); F.G = g_; F.vcu = v_; } } while (0)
    LAS int* lists = (LAS int*)(F.lds + LIST_OFF);

    if (PHON(0) && IN(0)) { PHASE_BEGIN(); p0_prologue(F, args); if (BOTH(0)) GRID_BAR(); }

    for (int L = 0; L < DEPTH; ++L) {
        const int pb = 1 + 8 * L;
        if (PHON(1) && IN(pb)) { PHASE_BEGIN();
            pg8::DenseOrder S; S.init(WSP(bf16, WS_WIN) + (size_t)L * NPROJ * 1024, NT, NPROJ, 1024, 1024, F.G, F.vcu);
            pg8::EpiProj E{WSP(bf16, WS_PROJ), WSP(float, WS_AUX), WSP(bf16, WS_IK)};
            pg8::gemm_phase<pg8::EpiProj, pg8::DenseOrder, true>(F.lds, lists, (LAS unsigned*)(F.lds + OFFS_OFF), (const char*)WSP(bf16, WS_XB), 1024, S, E, F.wave0);
            if (BOTH(pb)) GRID_BAR();
        }
        if (PHON(2) && IN(pb + 1)) { PHASE_BEGIN();
            const int nround = (F.G == 256) ? 9 : (1792 + 256 + 64 + F.G - 1) / F.G;
            TkPre tkpre; tkpre.a0 = bf16x8{}; tkpre.wq = f32x4{};
            for (int r = 0; r < nround; ++r) {
                const int u = (F.G == 256) ? (r * 256 + ((r & 1) ? 255 - F.vcu : F.vcu)) : (r * F.G + F.vcu);
                const int p2sel_ = args.rep ? P2REP_SEL : 7;
                if (p2sel_ & 1) if (u < 1792) {
                    int c, b, quarter, cn = -1; bool stage = true, havepre = false;
                    if (F.G == 256) { const int j = F.vcu >> 4, a = j >> 2; b = F.vcu & 15; quarter = j & 3; c = 31 - 4 * r - ((r & 1) ? 3 - a : a); stage = (r == 0); havepre = (r > 0);
                                      if (r < 6) cn = 31 - 4 * (r + 1) - (((r + 1) & 1) ? 3 - a : a); }
                    else { c = 31 - (u >> 6); const int rem = u & 63; b = rem >> 2; quarter = rem & 3; }
                    if (c < 8) topk_unit<16>(F, b, c, quarter, stage, havepre, cn, tkpre);
                    else if (c < 12) topk_unit<24>(F, b, c, quarter, stage, havepre, cn, tkpre);
                    else if (c < 16) topk_unit<32>(F, b, c, quarter, stage, havepre, cn, tkpre);
                    else if (c < 20) topk_unit<40>(F, b, c, quarter, stage, havepre, cn, tkpre);
                    else if (c < 24) topk_unit<48>(F, b, c, quarter, stage, havepre, cn, tkpre);
                    else if (c < 28) topk_unit<56>(F, b, c, quarter, stage, havepre, cn, tkpre);
                    else topk_unit<64>(F, b, c, quarter, stage, havepre, cn, tkpre);
                    __syncthreads();
                }
                if (p2sel_ & 2) if (u >= 1792 && u < 1792 + 256) mla_unit(F, args, L, u - 1792);
                if (p2sel_ & 4) if (u >= 1792 + 256 && u < 1792 + 256 + 64) cum_unit(F, args, L, u - 1792 - 256);
                if (p2sel_ & 4) if (r == nround - 1) knorm_jobs(F);
            }
            if (BOTH(pb + 1)) GRID_BAR();
        }
        if (PHON(3) && IN(pb + 2)) { PHASE_BEGIN();
            for (int uu = F.vcu; uu < 256; uu += F.G) {
                const int bh = uu >> 2, qa = uu & 3; const int p3sel_ = args.rep ? P3REP_SEL : 15;
#pragma unroll
                for (int half = 0; half < 2; ++half) if (p3sel_ & 1) attn64_unit<2>(F, args, L, bh >> 2, bh & 3, half ? qa : 7 - qa);
#pragma unroll
                for (int half = 0; half < 2; ++half) if (p3sel_ & 2) attn64_unit<1>(F, args, L, bh >> 2, bh & 3, half ? qa : 7 - qa);
#pragma unroll
                for (int half = 0; half < 2; ++half) if (p3sel_ & 8) attn64_unit<3>(F, args, L, bh >> 2, bh & 3, half ? qa : 7 - qa);
            }
            for (;;) { const int u = queue_next(F, L); if (u >= 512) break; attn64_unit<0>(F, args, L, (u & 63) >> 2, u & 3, 7 - (u >> 6)); }
            if (BOTH(pb + 2)) GRID_BAR();
        }
        if (PHON(4) && IN(pb + 3)) { PHASE_BEGIN();
            pg8::DenseOrder S; S.init(WSP(bf16, WS_WOUT) + (size_t)L * 1024 * 1024, NT, 1024, 1024, 1024, F.G, F.vcu);
            pg8::EpiOut E{WSP(bf16, WS_XB), WSP(bf16, WS_Y1)};
            pg8::gemm_phase<pg8::EpiOut, pg8::DenseOrder, true>(F.lds, lists, (LAS unsigned*)(F.lds + OFFS_OFF), (const char*)WSP(bf16, WS_MIXED), 1024, S, E, F.wave0);
            if (BOTH(pb + 3)) GRID_BAR();
        }
        if (PHON(5) && IN(pb + 4)) { PHASE_BEGIN();
            for (int u = F.vcu; u < NT / 128; u += F.G) ln1_router_unit(F, args, L, u);
            if (BOTH(pb + 4)) GRID_BAR();
        }
        if (PHON(6) && IN(pb + 5)) { PHASE_BEGIN();
            pg8::GroupedOrder<0> S; S.init(WSP(bf16, WS_WGU) + (size_t)L * 65 * 512 * 1024, WSP(int, WS_LIST), (const unsigned*)(F.ctl + CW_CNT + 64 * L), 512, 1024, 1024, F.G, F.vcu, F.lane, (LAS unsigned*)(F.lds + GRP_OFF));
            pg8::EpiGU<0> E{S, WSP(bf16, WS_ABUF), WSP(float, WS_GATE)};
            pg8::gemm_phase<pg8::EpiGU<0>, pg8::GroupedOrder<0>, true>(F.lds, lists, (LAS unsigned*)(F.lds + OFFS_OFF), (const char*)WSP(bf16, WS_XB), 1024, S, E, F.wave0);
            if (BOTH(pb + 5)) GRID_BAR();
        }
        if (PHON(7) && IN(pb + 6)) { PHASE_BEGIN();
            pg8::GroupedOrder<1> S; S.init(WSP(bf16, WS_WDN) + (size_t)L * 65 * 1024 * 256, WSP(int, WS_LIST), (const unsigned*)(F.ctl + CW_CNT + 64 * L), 1024, 256, 256, F.G, F.vcu, F.lane, (LAS unsigned*)(F.lds + GRP_OFF));
            pg8::EpiDown<1> E{S, WSP(bf16, WS_YBUF), (P7_PROBE_NOSTORE && args.rep) ? 1 : 0};
            pg8::gemm_phase<pg8::EpiDown<1>, pg8::GroupedOrder<1>, P7_ALIGN>(F.lds, lists, (LAS unsigned*)(F.lds + OFFS_OFF), (const char*)WSP(bf16, WS_ABUF), 256, S, E, F.wave0);
            if (BOTH(pb + 6)) GRID_BAR();
        }
        if (PHON(8) && IN(pb + 7)) { PHASE_BEGIN();
            reduce_ln2_rows(F, args, L, L == DEPTH - 1);
            if (BOTH(pb + 7)) GRID_BAR();
        }
    }
#undef IN
#undef BOTH
#undef GRID_BAR
}

#ifdef DBG_STOP
struct DbgBuf { const unsigned short* p; unsigned long long n; };
struct DbgArgs { DbgBuf b[6]; int nb; int pad; };
__global__ void dbg_copy(DbgArgs d, float* out, int nout) {
    for (long long i = blockIdx.x * (long long)blockDim.x + threadIdx.x; i < nout; i += (long long)gridDim.x * blockDim.x) {
        float acc = 0.f;
        for (int b = 0; b < d.nb; ++b) { const unsigned long long stride = (d.b[b].n + (unsigned long long)nout - 1) / (unsigned long long)nout; const unsigned long long j = (unsigned long long)i * stride; if (j < d.b[b].n) acc += (float)d.b[b].p[j]; }
        out[i] = acc;
    }
}
#endif
extern "C" void kernel_launch(void* const* d_in, const int* in_sizes, int n_in, void* d_out, int out_size, void* d_ws, size_t ws_size, hipStream_t stream) {
    static int grid = 0;
    if (grid == 0) {
        if (n_in != 20 || out_size != NT * DM || ws_size < WS_END) { fprintf(stderr, "kernel_launch: unexpected shapes (n_in %d out %d ws %zu)\n", n_in, out_size, ws_size); grid = -1; return; }
        int dev = 0, cus = 0, per_cu = 0;
        if (hipGetDevice(&dev) != hipSuccess || hipDeviceGetAttribute(&cus, hipDeviceAttributeMultiprocessorCount, dev) != hipSuccess) { grid = -1; return; }
        if (hipFuncSetAttribute((const void*)mk_fwd, hipFuncAttributeMaxDynamicSharedMemorySize, LDS_BYTES) != hipSuccess) { fprintf(stderr, "kernel_launch: hipFuncSetAttribute failed\n"); grid = -1; return; }
        if (hipOccupancyMaxActiveBlocksPerMultiprocessor(&per_cu, (const void*)mk_fwd, 512, LDS_BYTES) != hipSuccess || per_cu < 1) fprintf(stderr, "kernel_launch: occupancy query reports %d\n", per_cu);
        (void)hipGetLastError();
        grid = cus;
    }
    if (grid < 0) return;
    (void)hipMemsetAsync((char*)d_ws + WS_CTL, 0, CTL_ZERO_BYTES, stream);
    Args a{};
    for (int i = 0; i < 20; ++i) a.in[i] = (const float*)d_in[i];
    a.out = (float*)d_out; a.ws = (unsigned char*)d_ws;
#ifdef DBG_STOP
    for (int p = 0; p <= DBG_STOP; ++p) { a.ph_lo = p; a.ph_hi = p + 1; hipLaunchKernelGGL(mk_fwd, dim3(grid), dim3(512), LDS_BYTES, stream, a); }
    { DbgArgs d{}; const unsigned char* w = (const unsigned char*)d_ws; int nb = 0;
#define DB(off, bytes) d.b[nb].p = (const unsigned short*)(w + (off)); d.b[nb].n = (unsigned long long)(bytes) / 2; ++nb;
      DBG_BUFS
#undef DB
      d.nb = nb; hipLaunchKernelGGL(dbg_copy, dim3(2048), dim3(256), 0, stream, d, (float*)d_out, out_size); }
#elif MK_MULTI
#ifdef REPEAT_PHASE
    for (int p = 0; p < NPH; ++p) { a.ph_lo = p; a.ph_hi = p + 1; a.rep = 0; hipLaunchKernelGGL(mk_fwd, dim3(grid), dim3(512), LDS_BYTES, stream, a);
        if ((p >= 1 && ((p - 1) % 8) + 1 == REPEAT_PHASE) || (p == 0 && REPEAT_PHASE == 0)) { a.rep = 1; hipLaunchKernelGGL(mk_fwd, dim3(grid), dim3(512), LDS_BYTES, stream, a); } }
#else
    for (int p = 0; p < NPH; ++p) { a.ph_lo = p; a.ph_hi = p + 1; hipLaunchKernelGGL(mk_fwd, dim3(grid), dim3(512), LDS_BYTES, stream, a); }
#endif
#else
    a.ph_lo = 0; a.ph_hi = NPH;
    hipLaunchKernelGGL(mk_fwd, dim3(grid), dim3(512), LDS_BYTES, stream, a);
#endif
    (void)in_sizes;
}
```

```cpp
#include <hip/hip_runtime.h>
#include <cstdio>
#include <cstdint>
#include <cmath>

#define GAS __attribute__((address_space(1)))
#define LAS __attribute__((address_space(3)))
typedef unsigned short bf16;
typedef unsigned v4u __attribute__((ext_vector_type(4)));
typedef unsigned v2u __attribute__((ext_vector_type(2)));
typedef float f32x4 __attribute__((ext_vector_type(4)));
typedef float f32x2 __attribute__((ext_vector_type(2)));
typedef float f32x16 __attribute__((ext_vector_type(16)));
typedef short bf16x8 __attribute__((ext_vector_type(8)));
typedef short s16x4 __attribute__((ext_vector_type(4)));
typedef GAS unsigned gu32;
#define RLX_AGENT __ATOMIC_RELAXED, __HIP_MEMORY_SCOPE_AGENT
#define LDS_WAIT() asm volatile("s_waitcnt lgkmcnt(0)" ::: "memory")
#define VM_WAIT() asm volatile("s_waitcnt vmcnt(0)" ::: "memory")

constexpr int DM = 1024, NB = 16, SEQ = 2048, DEPTH = 4, NT = NB * SEQ;
constexpr int NPROJ = 3072;
constexpr int NE = 64, TOPK = 8, DEXP = 256;
constexpr int PC_FOX = 0, PC_DSA = 768, PC_BAND = 1536, PC_IQ = 2304, PC_CQ = 2560, PC_CKV = 2752, PC_KR = 2880, PC_IK = 2912, PC_IW = 2944, PC_FF = 2952, PC_END = 2956;
constexpr float LOG2E = 1.4426950408889634f;
constexpr float QSCALE64 = 0.125f * LOG2E;
constexpr float QSCALE96 = 0.10206207261596575f * LOG2E;
constexpr float ALPHA = 1.6817928305074290f;
constexpr float LN_EPS = 1e-5f, RMS_EPS = 1e-6f;
#ifndef YFP8
#define YFP8 1
#endif
constexpr float YSCALE = 64.0f, YINV = 1.0f / 64.0f;

constexpr size_t MiB = 1u << 20;
constexpr size_t WS_CTL = 0, CTL_ZERO_BYTES = 1 * MiB;
constexpr size_t WS_XB = 1 * MiB;
constexpr size_t WS_PROJ = 65 * MiB;
constexpr size_t WS_AUX = 257 * MiB;
constexpr size_t WS_QMLA = 259 * MiB;
constexpr size_t WS_KMLA = 283 * MiB;
constexpr size_t WS_VMLA = 307 * MiB;
constexpr size_t WS_CUM = 323 * MiB;
constexpr size_t WS_KNORM = WS_CUM + 512 * 1024;
constexpr size_t WS_MASK = 324 * MiB;
constexpr size_t WS_MIXED = 332 * MiB;
constexpr size_t WS_Y1 = 396 * MiB;
constexpr size_t WS_LIST = 460 * MiB;
constexpr size_t WS_GATE = 468 * MiB;
constexpr size_t WS_ABUF = 469 * MiB;
constexpr size_t WS_YBUF = 629 * MiB;
constexpr size_t WS_WIN = 1237 * MiB;
constexpr size_t WS_WOUT = 1261 * MiB;
constexpr size_t WS_WGU = 1269 * MiB;
constexpr size_t WS_WDN = 1529 * MiB;
constexpr size_t WS_WUQ = 1659 * MiB;
constexpr size_t WS_WUKV = 1660 * MiB;
constexpr size_t WS_WRH = 1661 * MiB;
constexpr size_t WS_WRL = 1662 * MiB;
constexpr size_t WS_IK = 1663 * MiB;
constexpr size_t WS_SREF = 1665 * MiB;
constexpr size_t WS_END = 1666 * MiB;
static_assert(WS_YBUF + (size_t)311296 * 1024 * 2 <= WS_WIN && WS_ABUF + (size_t)311296 * 256 * 2 <= WS_YBUF, "ws map");
static_assert(WS_WGU + (size_t)4 * 65 * 512 * 1024 * 2 <= WS_WDN && WS_WDN + (size_t)4 * 65 * 1024 * 256 * 2 <= WS_WUQ, "ws map w");
constexpr int CW_TMO = 0, CW_CODE = 1;
constexpr int CW_BAR = 4096;
constexpr int CW_Q = 8192;
constexpr int CW_CNT = 16384;
constexpr int RING_BYTES = 131072;
constexpr int LIST_OFF = RING_BYTES;
constexpr int OFFS_OFF = RING_BYTES + 3072;
constexpr int LDSCTL_OFF = RING_BYTES + 6144, MISC_OFF = LDSCTL_OFF;
constexpr int GRP_OFF = MISC_OFF + 256;
constexpr int LDS_BYTES = 147456;
static_assert(GRP_OFF + 512 <= LDS_BYTES, "LDS map");

__device__ __forceinline__ unsigned f2bf(float f) { unsigned u = __builtin_bit_cast(unsigned, f); return (u + 0x7fffu + ((u >> 16) & 1u)) >> 16; }

__device__ __forceinline__ float bf2f(unsigned h) { return __builtin_bit_cast(float, h << 16); }
__device__ __forceinline__ float bflo(unsigned w) { return __builtin_bit_cast(float, w << 16); }
__device__ __forceinline__ float bfhi(unsigned w) { return __builtin_bit_cast(float, w & 0xffff0000u); }
typedef float f32x2_t __attribute__((ext_vector_type(2))); typedef __bf16 bf16x2_t __attribute__((ext_vector_type(2)));
__device__ __forceinline__ unsigned cvt_pk_bf16(float lo, float hi) { f32x2_t v = {lo, hi}; bf16x2_t b = __builtin_convertvector(v, bf16x2_t); return __builtin_bit_cast(unsigned, b); }
__device__ __forceinline__ unsigned pk2(float lo, float hi) { return cvt_pk_bf16(lo, hi); }
__device__ __forceinline__ float fmul_s(float a, float b) { float r; asm("v_mul_f32_e32 %0, %1, %2" : "=v"(r) : "v"(a), "v"(b)); return r; }
__device__ __forceinline__ float ffma_s(float a, float b, float c) { float r; asm("v_fma_f32 %0, %1, %2, %3" : "=v"(r) : "v"(a), "v"(b), "v"(c)); return r; }
__device__ __forceinline__ float fadd_s(float a, float b) { float r; asm("v_add_f32_e32 %0, %1, %2" : "=v"(r) : "v"(a), "v"(b)); return r; }
__device__ __forceinline__ float fmax0_s(float a) { float r; asm("v_max_f32_e32 %0, 0, %1" : "=v"(r) : "v"(a)); return r; }
#define DPP_ADD_F(v, CTRL) ((v) + __builtin_bit_cast(float, __builtin_amdgcn_update_dpp(0, __builtin_bit_cast(int, (v)), (CTRL), 0xF, 0xF, true)))
__device__ __forceinline__ float wave_sum(float v) {
    v = DPP_ADD_F(v, 0xB1); v = DPP_ADD_F(v, 0x4E); v = DPP_ADD_F(v, 0x141); v = DPP_ADD_F(v, 0x140);
    { auto r = __builtin_amdgcn_permlane16_swap(__builtin_bit_cast(unsigned, v), __builtin_bit_cast(unsigned, v), false, false); const unsigned a_ = r[0], b_ = r[1]; v = __uint_as_float(a_) + __uint_as_float(b_); }
    { auto r = __builtin_amdgcn_permlane32_swap(__builtin_bit_cast(unsigned, v), __builtin_bit_cast(unsigned, v), false, false); const unsigned a_ = r[0], b_ = r[1]; v = __uint_as_float(a_) + __uint_as_float(b_); }
    return v;
}
#define DPP_MAX_F(v, CTRL) fmaxf((v), __builtin_bit_cast(float, __builtin_amdgcn_update_dpp(0, __builtin_bit_cast(int, (v)), (CTRL), 0xF, 0xF, true)))
__device__ __forceinline__ float wave_max_nn(float v) {
    v = DPP_MAX_F(v, 0xB1); v = DPP_MAX_F(v, 0x4E); v = DPP_MAX_F(v, 0x141); v = DPP_MAX_F(v, 0x140);
    { auto r = __builtin_amdgcn_permlane16_swap(__builtin_bit_cast(unsigned, v), __builtin_bit_cast(unsigned, v), false, false); const unsigned a_ = r[0], b_ = r[1]; v = fmaxf(__uint_as_float(a_), __uint_as_float(b_)); }
    { auto r = __builtin_amdgcn_permlane32_swap(__builtin_bit_cast(unsigned, v), __builtin_bit_cast(unsigned, v), false, false); const unsigned a_ = r[0], b_ = r[1]; v = fmaxf(__uint_as_float(a_), __uint_as_float(b_)); }
    return v;
}
__device__ __forceinline__ float swap32_add(float v) { auto r = __builtin_amdgcn_permlane32_swap(__builtin_bit_cast(unsigned, v), __builtin_bit_cast(unsigned, v), false, false); const unsigned a_ = r[0], b_ = r[1]; return __uint_as_float(a_) + __uint_as_float(b_); }
__device__ __forceinline__ float swap32_max(float v) { auto r = __builtin_amdgcn_permlane32_swap(__builtin_bit_cast(unsigned, v), __builtin_bit_cast(unsigned, v), false, false); const unsigned a_ = r[0], b_ = r[1]; return fmaxf(__uint_as_float(a_), __uint_as_float(b_)); }

__device__ __forceinline__ int lane_id_now() { int l; asm volatile("v_mbcnt_lo_u32_b32 %0, -1, 0\n\tv_mbcnt_hi_u32_b32 %0, -1, %0" : "=v"(l)); return l; }
#define XB_TMO      128
#define XB_XCNT(j)  (256  + 64 * (j))
#define XB_XSUB(j)  (1280 + 64 * (j))
#define XB_XGEN(j)  (2304 + 64 * (j))
#define XB_TOP      3328
#define XB_TOPGEN   3392
#define XCD_BAR_WORDS 3456
#define XB_SPIN_CAP (1u << 23)
__device__ __forceinline__ unsigned xb_ld(unsigned* p)              { return __hip_atomic_load(p, __ATOMIC_RELAXED, __HIP_MEMORY_SCOPE_AGENT); }
__device__ __forceinline__ unsigned xb_add(unsigned* p, unsigned v) { return __hip_atomic_fetch_add(p, v, __ATOMIC_RELAXED, __HIP_MEMORY_SCOPE_AGENT); }
__device__ __forceinline__ unsigned xb_xcc_id() { return (unsigned)__builtin_amdgcn_s_getreg((3 << 11) | 20) & 0xFu; }
#define XB_SPIN(cond, bar) do { unsigned _sp = 0; while (cond) { __builtin_amdgcn_s_sleep(1); \
    if ((++_sp & 255u) == 0u) { if (xb_ld(&(bar)[XB_TMO])) break; if (_sp > XB_SPIN_CAP) { atomicAdd(&(bar)[XB_TMO], 1u); break; } } } } while (0)
struct XcdBarrier { unsigned* bar; unsigned x; volatile LAS unsigned* st; };
__device__ __forceinline__ XcdBarrier xcd_barrier_post(unsigned* bar, volatile LAS unsigned* st, bool leader) {
    XcdBarrier b; b.bar = bar; b.x = xb_xcc_id(); b.st = st;
    if (leader) (void)xb_add(&bar[XB_XCNT(b.x)], 1u);
    return b;
}
__device__ __forceinline__ void xcd_barrier_complete(unsigned* bar, unsigned x, unsigned& nloc, unsigned& nx) {
    const unsigned G = gridDim.x * gridDim.y * gridDim.z;
    unsigned sum, cnt, mine, sp = 0u;
    for (;;) {
        sum = 0u; cnt = 0u; mine = 0u;
#pragma unroll
        for (unsigned j = 0; j < 16; ++j) { const unsigned c = xb_ld(&bar[XB_XCNT(j)]); sum += c; cnt += (c > 0u) ? 1u : 0u; mine = (j == x) ? c : mine; }
        if (sum == G) break;
        __builtin_amdgcn_s_sleep(1);
        if ((++sp & 255u) == 0u) { if (xb_ld(&bar[XB_TMO])) break; if (sp > XB_SPIN_CAP) { atomicAdd(&bar[XB_TMO], 1u); break; } }
    }
    nloc = mine > 0u ? mine : 1u; nx = cnt > 0u ? cnt : 1u;
}
__device__ __forceinline__ void xcd_barrier(const XcdBarrier& b, bool leader) {
    asm volatile("s_waitcnt vmcnt(0)" ::: "memory");
    __syncthreads();
    if (leader) {
        unsigned* bar = b.bar; unsigned bx_ = b.x;
        asm volatile("" : "+s"(bar), "+s"(bx_));
        __builtin_amdgcn_s_waitcnt(0);
        unsigned nloc = b.st[0], nx = b.st[1];
        if (nloc == 0u) { xcd_barrier_complete(bar, bx_, nloc, nx); b.st[0] = nloc; b.st[1] = nx; }
        const unsigned old = xb_add(&bar[XB_XSUB(bx_)], 1u);
        const unsigned gen = old / nloc;
        if (old + 1u == (gen + 1u) * nloc) {
            __builtin_amdgcn_fence(__ATOMIC_RELEASE, "agent");
            asm volatile("s_waitcnt vmcnt(0)" ::: "memory");
            const unsigned og = xb_add(&bar[XB_TOP], 1u);
            const unsigned tg = og / nx;
            if (og + 1u == (tg + 1u) * nx) xb_add(&bar[XB_TOPGEN], 1u);
            else XB_SPIN(xb_ld(&bar[XB_TOPGEN]) == tg, bar);
            __builtin_amdgcn_fence(__ATOMIC_ACQUIRE, "agent");
            xb_add(&bar[XB_XGEN(bx_)], 1u);
            asm volatile("s_waitcnt vmcnt(0)" ::: "memory");
        } else {
            XB_SPIN(xb_ld(&bar[XB_XGEN(bx_)]) == gen, bar);
            __builtin_amdgcn_fence(__ATOMIC_ACQUIRE, "agent");
            asm volatile("s_waitcnt vmcnt(0)" ::: "memory");
        }
    }
    __syncthreads();
}
namespace pg8 {
constexpr int BM = 256, BK = 64, HALF = 128, HTB = HALF * BK * 2, STAGE_BYTES = 8 * HTB;
__host__ __device__ __forceinline__ int lds_byte(int r, int c) { const int st = (r >> 4) * 2 + (c >> 5), rr = r & 15, cc = c & 31, ob = rr * 64 + cc * 2; return st * 1024 + (ob ^ (((ob >> 9) & 1) << 5)); }
__host__ __device__ __forceinline__ void stage_rc(int b, int& R, int& C) { const int st = b / 1024, sb = b % 1024, swz = sb ^ (((sb >> 9) & 1) << 5); R = (st >> 1) * 16 + swz / 64; C = (st & 1) * 32 + (swz % 64) / 2; }
__host__ __device__ __forceinline__ int perm32(int rho) { const int n = rho >> 4, i = rho & 15; return 8 * (i >> 2) + 4 * n + (i & 3); }

struct Unit { int pm, pn, grp, cnt, sb; };

template <class Epi, class Sched, bool ALIGN_EPI>
__device__ __forceinline__ void gemm_phase(LAS unsigned char* lds, LAS int* lists  , LAS unsigned* offs  , const char* Abase, int K, const Sched& S, const Epi& E, int wave_u) {
    int tid_ = wave_u * 64 + lane_id_now();
    const int tid = tid_, wid = __builtin_amdgcn_readfirstlane(tid >> 6), lane = tid & 63, wr = wid >> 2, wc = wid & 3, fr = lane & 15, fq = lane >> 4;
    const int nt = K / BK;
    asm volatile("" : "+s"(Abase));
    int Rr[2]; unsigned Cb[2], voffB[2];
#pragma unroll
    for (int i = 0; i < 2; ++i) { int R, C; stage_rc(tid * 16 + i * 8192, R, C); int Rb = (R & ~31) + perm32(R & 31);
        if constexpr (Epi::COL16) Rb = 64 * (Rb >> 5) + 16 * ((Rb >> 3) & 3) + (Rb & 7);
        Rr[i] = R; Cb[i] = (unsigned)C * 2u; voffB[i] = (unsigned)(Rb * K + C) * 2u; }
    const size_t kstep = (size_t)(BK * 2);
    const size_t hstepB = (size_t)(Epi::COL16 ? 8 : HALF) * K * 2;
    const unsigned ldsw = (unsigned)wid * 1024u;
    const int aoff = lds_byte(wr * 64 + fr, fq * 8), boff = lds_byte(wc * 32 + fr, fq * 8);
#define PG8_SA(b, h) (((b) * 2 + (h)) * HTB)
#define PG8_SB(b, h) ((4 + (b) * 2 + (h)) * HTB)
#define PG8_STAGEB(bufoff, gbase) do { _Pragma("unroll") for (int _i = 0; _i < 2; ++_i) { unsigned vo_ = voffB[_i]; asm volatile("" : "+v"(vo_));   \
        __builtin_amdgcn_global_load_lds((const unsigned*)((const char*)(gbase) + vo_), (LAS unsigned*)(lds + (bufoff) + ldsw + _i * 8192), 16, 0, 0); } } while (0)
#define PG8_LDA(dst, b, h) do { _Pragma("unroll") for (int m = 0; m < 4; ++m) _Pragma("unroll") for (int k = 0; k < 2; ++k) dst[m][k] = *(const LAS bf16x8*)(lds + PG8_SA(b, h) + aoff + m * 2048 + k * 1024); } while (0)
#define PG8_LDB(dst, b, h) do { _Pragma("unroll") for (int n = 0; n < 2; ++n) _Pragma("unroll") for (int k = 0; k < 2; ++k) dst[n][k] = *(const LAS bf16x8*)(lds + PG8_SB(b, h) + boff + n * 2048 + k * 1024); } while (0)
#define PG8_MMA(ai, bj, At, Bt) do { __builtin_amdgcn_s_setprio(1); _Pragma("unroll") for (int m = 0; m < 4; ++m) _Pragma("unroll") for (int n = 0; n < 2; ++n) _Pragma("unroll") for (int k = 0; k < 2; ++k) \
        acc[ai][bj][m][n] = __builtin_amdgcn_mfma_f32_16x16x32_bf16(Bt[n][k], At[m][k], acc[ai][bj][m][n], 0, 0, 0); __builtin_amdgcn_s_setprio(0); } while (0)
#define PG8_WAIT_V(n) asm volatile("s_waitcnt vmcnt(" #n ")" ::: "memory")
#define PG8_WAIT_L(n) asm volatile("s_waitcnt lgkmcnt(" #n ")" ::: "memory")
#define PG8_BAR __builtin_amdgcn_s_barrier()
#define PG8_SCHED __builtin_amdgcn_sched_barrier(0)
    Unit cur, nxt; int ui = 0;
    if (!S.next(0, cur)) return;
    unsigned voffA[2] = {0u, 0u};
    size_t cAu = 0, nAu = 0; const size_t hstepA = (size_t)HALF * S.lda2;
    if constexpr (!Sched::GATHER) {
#pragma unroll
        for (int i = 0; i < 2; ++i) voffA[i] = (unsigned)Rr[i] * S.lda2 + Cb[i];
        cAu = (size_t)S.arow(cur, 0, 0);
    }
    unsigned Rb4[2] = {0u, 0u};
    if constexpr (Sched::LIST) {
        if (wid == 0) __builtin_amdgcn_global_load_lds((const unsigned*)(S.list_ptr(cur) + lane * 4), (LAS unsigned*)(lists), 16, 0, 0);
        PG8_WAIT_V(0); __syncthreads();
    }
    if constexpr (Sched::GATHER) {
#pragma unroll
        for (int i = 0; i < 2; ++i) Rb4[i] = (unsigned)Rr[i] * 4u;
        if (tid < 256) offs[tid] = S.arow(cur, tid, lists[tid]);
        __syncthreads();
    }
#define PG8_APRE(h, OT) unsigned ao_[2]; do { _Pragma("unroll") for (int _i = 0; _i < 2; ++_i) { if constexpr (Sched::GATHER) ao_[_i] = *(const LAS unsigned*)((const LAS unsigned char*)(OT) + (h) * (HALF * 4) + Rb4[_i]) + Cb[_i]; else ao_[_i] = voffA[_i]; } } while (0)
#define PG8_STAGEA(bufoff, UBASE, h, kb) do { const char* ub_ = Sched::GATHER ? (Abase + (size_t)(kb)) : (Abase + (UBASE) + (h) * hstepA + (size_t)(kb)); _Pragma("unroll") for (int _i = 0; _i < 2; ++_i) { unsigned vo_ = ao_[_i]; asm volatile("" : "+v"(vo_)); \
        __builtin_amdgcn_global_load_lds((const unsigned*)(ub_ + vo_), (LAS unsigned*)(lds + (bufoff) + ldsw + _i * 8192), 16, 0, 0); } } while (0)
    f32x4 acc[2][2][4][2];
#pragma unroll
    for (int a = 0; a < 2; ++a)
#pragma unroll
        for (int b = 0; b < 2; ++b)
#pragma unroll
            for (int m = 0; m < 4; ++m)
#pragma unroll
                for (int n = 0; n < 2; ++n) acc[a][b][m][n] = (f32x4){0.f, 0.f, 0.f, 0.f};
    bf16x8 At[4][2], B0[2][2], B1[2][2];
    const char* cB = S.bptr(cur); asm volatile("" : "+s"(cB));
    { PG8_APRE(0, offs); PG8_STAGEB(PG8_SB(0, 0), cB); PG8_STAGEB(PG8_SB(0, 1), cB + hstepB); PG8_STAGEA(PG8_SA(0, 0), cAu, 0, 0); }
    { PG8_APRE(1, offs); PG8_STAGEA(PG8_SA(0, 1), cAu, 1, 0); }
    if (wr == 1) PG8_BAR;
    PG8_WAIT_V(2); PG8_BAR;
    { PG8_APRE(0, offs); PG8_STAGEB(PG8_SB(1, 0), cB + kstep); PG8_STAGEA(PG8_SA(1, 0), cAu, 0, kstep); PG8_STAGEB(PG8_SB(1, 1), cB + hstepB + kstep); }
    PG8_WAIT_V(6); PG8_BAR;
#define PG8_TRIP(ON, NUB, k1, k2, k3, b2, b3, PRE) do { \
            { PG8_APRE(1, ocur); PRE; PG8_LDB(B0, 0, 0); PG8_LDB(B1, 0, 1); PG8_SCHED; PG8_LDA(At, 0, 0); PG8_STAGEA(PG8_SA(1, 1), cAu, 1, k1); } \
            PG8_WAIT_V(8); PG8_WAIT_L(0); PG8_BAR; PG8_MMA(0, 0, At, B0); PG8_MMA(0, 1, At, B1); PG8_BAR; PG8_SCHED; \
            { PG8_APRE(0, ON); PG8_LDA(At, 0, 1); PG8_STAGEB(PG8_SB(0, 0), b2); PG8_STAGEB(PG8_SB(0, 1), b2 + hstepB); PG8_STAGEA(PG8_SA(0, 0), NUB, 0, k2); } \
            PG8_WAIT_V(8); PG8_WAIT_L(0); PG8_BAR; PG8_MMA(1, 0, At, B0); PG8_MMA(1, 1, At, B1); PG8_BAR; PG8_SCHED; \
            { PG8_APRE(1, ON); PG8_LDB(B0, 1, 0); PG8_LDB(B1, 1, 1); PG8_SCHED; PG8_LDA(At, 1, 0); PG8_STAGEA(PG8_SA(0, 1), NUB, 1, k2); } \
            PG8_WAIT_V(8); PG8_WAIT_L(0); PG8_BAR; PG8_MMA(0, 0, At, B0); PG8_MMA(0, 1, At, B1); PG8_BAR; PG8_SCHED; \
            { PG8_APRE(0, ON); PG8_LDA(At, 1, 1); PG8_STAGEB(PG8_SB(1, 0), b3); PG8_STAGEB(PG8_SB(1, 1), b3 + hstepB); PG8_STAGEA(PG8_SA(1, 0), NUB, 0, k3); } \
            PG8_WAIT_V(8); PG8_WAIT_L(0); PG8_BAR; PG8_MMA(1, 0, At, B0); PG8_MMA(1, 1, At, B1); PG8_BAR; PG8_SCHED; } while (0)
    for (;;) {
        const bool has_next = S.next(ui + 1, nxt);
        const char* nB = has_next ? S.bptr(nxt) : cB; asm volatile("" : "+s"(nB));
        LAS int* lcur = lists + (ui % 3) * 256; LAS int* lnxt = lists + ((ui + 1) % 3) * 256;
        LAS unsigned* ocur = offs + (ui % 3) * 256; LAS unsigned* onxt = offs + ((ui + 1) % 3) * 256;
        if constexpr (Sched::LIST) { if (has_next && wid == 0) __builtin_amdgcn_global_load_lds((const unsigned*)(S.list_ptr(nxt) + lane_id_now() * 4), (LAS unsigned*)(lnxt), 16, 0, 0); }
        for (int t = 0; t < nt - 2; t += 2) {
            const size_t k1 = (size_t)(t + 1) * kstep, k2 = (size_t)(t + 2) * kstep, k3 = k2 + kstep;
            const char* b2 = cB + k2; const char* b3 = b2 + kstep;
            PG8_TRIP(ocur, cAu, k1, k2, k3, b2, b3, (void)0);
        }
        {
            if (!has_next) { nxt = cur; lnxt = lcur; }
            if constexpr (!Sched::GATHER) nAu = (size_t)S.arow(nxt, 0, 0);
            const size_t k1 = (size_t)(nt - 1) * kstep;
            const char* b2 = nB; const char* b3 = nB + kstep;
            PG8_TRIP(onxt, nAu, k1, (size_t)0, kstep, b2, b3, do { if constexpr (Sched::GATHER) { if (wr == 0) { const int t3_ = wave_u * 64 + lane_id_now(); onxt[t3_] = S.arow(nxt, t3_, lnxt[t3_]); } } } while (0));
            if constexpr (ALIGN_EPI) { if (wr == 0) PG8_BAR; }
            asm volatile("" ::: "memory"); __builtin_amdgcn_sched_barrier(0);
            { const int ln2_ = lane_id_now();
              E(acc, cur, lcur, wr, wc, ln2_ & 15, ln2_ >> 4); }
            asm volatile("" ::: "memory"); __builtin_amdgcn_sched_barrier(0);
            if (!has_next) break;
            cAu = nAu;
        }
#pragma unroll
        for (int a = 0; a < 2; ++a)
#pragma unroll
            for (int b = 0; b < 2; ++b)
#pragma unroll
                for (int m = 0; m < 4; ++m)
#pragma unroll
                    for (int n = 0; n < 2; ++n) acc[a][b][m][n] = (f32x4){0.f, 0.f, 0.f, 0.f};
        cur = nxt; cB = nB; ++ui;
        if constexpr (ALIGN_EPI) { if (wr == 1) PG8_BAR; }
    }
    PG8_WAIT_V(0);
    if constexpr (!ALIGN_EPI) { if (wr == 0) PG8_BAR; }
    PG8_BAR;
#undef PG8_TRIP
#undef PG8_APRE
#undef PG8_STAGEA
#undef PG8_SA
#undef PG8_SB
#undef PG8_STAGEB
#undef PG8_LDA
#undef PG8_LDB
#undef PG8_MMA
#undef PG8_WAIT_V
#undef PG8_WAIT_L
#undef PG8_BAR
#undef PG8_SCHED
}
}
namespace pg8 {
struct DenseOrder {
    static constexpr bool GATHER = false, LIST = false;
    const char* Bt; int nM, nN, nwg, G, c, K; unsigned lda2;
    __device__ __forceinline__ void init(const void* Bt_, int M, int N, int K_, int lda_elems, int G_, int c_) { Bt = (const char*)Bt_; nM = M / BM; nN = N / BM; nwg = nM * nN; G = G_; c = c_; K = K_; lda2 = (unsigned)lda_elems * 2u; }
    __device__ __forceinline__ bool next(int i, Unit& u) const {
        const int L = i * G + c; if (L >= nwg) return false;
        const int nig = 8 * nN, gid = L / nig, r = L % nig;
        u.pm = gid * 8 + (r & 7); u.pn = r >> 3; u.grp = 0; u.cnt = 1 << 30; u.sb = 0; return true;
    }
    __device__ __forceinline__ const char* bptr(const Unit& u) const { return Bt + (size_t)u.pn * BM * K * 2; }
    __device__ __forceinline__ const int* list_ptr(const Unit&) const { return nullptr; }
    __device__ __forceinline__ unsigned arow(const Unit& u, int row, int) const { return (unsigned)(u.pm * BM + row) * lda2; }
};
template <int MODE>
struct GroupedOrder {
    static constexpr bool GATHER = (MODE == 0), LIST = (MODE == 0);
    const char* Bt; const int* list; int nN, G, c, K, N; unsigned lda2;
    LAS unsigned* lpre; LAS unsigned* lcnt; int total;
    __device__ __forceinline__ void init(const void* Bt_, const int* list_, const unsigned* counts, int N_, int K_, int lda_elems, int G_, int c_, int lane_, LAS unsigned* grp) {
        Bt = (const char*)Bt_; list = list_; N = N_; nN = N_ / BM; K = K_; G = G_; c = c_; lda2 = (unsigned)lda_elems * 2u; const int lane = lane_; lpre = grp; lcnt = grp + 64;
        unsigned cnt_lane = __hip_atomic_load(counts + lane, __ATOMIC_RELAXED, __HIP_MEMORY_SCOPE_AGENT);
        if (cnt_lane > (unsigned)NT) cnt_lane = NT;
        const unsigned nt_ = (cnt_lane + 255u) >> 8; unsigned pre = 0u; int tot = 0;
#pragma unroll
        for (int j = 0; j < 64; ++j) { const int v = __builtin_amdgcn_readlane((int)nt_, j); pre += (j < lane) ? (unsigned)v : 0u; tot += v; }
        total = tot;
        lpre[lane] = pre; lcnt[lane] = cnt_lane;
        __syncthreads();
    }
    __device__ __forceinline__ bool next(int i, Unit& u) const {
        const int L = i * G + c, t = L / nN; u.pn = L % nN;
        const int nsh = NT / BM;
        if (t >= nsh + total) return false;
        if (t < nsh) { u.grp = 64; u.pm = t; u.cnt = NT; u.sb = 256 * (total + t); return true; }
        const int tt = t - nsh;
        const unsigned long long m = __ballot(lpre[lane_id_now()] <= (unsigned)tt);
        const int g = __popcll(m) - 1;
        const int pg_ = __builtin_amdgcn_readfirstlane((int)lpre[g]); u.grp = g; u.pm = tt - pg_; u.cnt = __builtin_amdgcn_readfirstlane((int)lcnt[g]); u.sb = 256 * tt; return true;
    }
    __device__ __forceinline__ const char* bptr(const Unit& u) const { return Bt + ((size_t)u.grp * N + (size_t)u.pn * BM) * K * 2; }
    __device__ __forceinline__ const int* list_ptr(const Unit& u) const { return list + (size_t)(u.grp & 63) * NT + u.pm * BM; }
    __device__ __forceinline__ int rid_of(const Unit& u, int row, int rid_list) const {
        const int r = u.pm * BM + row;
        if (u.grp == 64) return 8 * NT + r;
        return (r < u.cnt) ? (rid_list & 0x3ffff) : 0;
    }
    __device__ __forceinline__ unsigned arow(const Unit& u, int row, int rid_list) const {
        if (MODE == 1) return (unsigned)(u.sb + row) * lda2;
        const int rid = rid_of(u, row, rid_list);
        const int tok = (rid >= 8 * NT) ? rid - 8 * NT : (rid >> 3); return (unsigned)tok * lda2;
    }
};

struct EpiProj {
    static constexpr bool COL16 = false;
    bf16* proj; float* aux; bf16* ik;
    __device__ __forceinline__ void operator()(const f32x4 (&acc)[2][2][4][2], const Unit& u, LAS int*, int wr, int wc, int fr, int fq) const {
        const int row0 = u.pm * BM + wr * 64 + fr, col0 = u.pn * BM + wc * 32 + 8 * fq;
#pragma unroll
        for (int ai = 0; ai < 2; ++ai)
#pragma unroll
            for (int m = 0; m < 4; ++m) { const int row = row0 + ai * HALF + m * 16; bf16* rowp = proj + (size_t)row * NPROJ + col0;
#pragma unroll
                for (int bj = 0; bj < 2; ++bj) { const f32x4 v0 = acc[ai][bj][m][0], v1 = acc[ai][bj][m][1];
                    v4u w; w.x = cvt_pk_bf16(v0[0], v0[1]); w.y = cvt_pk_bf16(v0[2], v0[3]); w.z = cvt_pk_bf16(v1[0], v1[1]); w.w = cvt_pk_bf16(v1[2], v1[3]);
                    *(v4u*)(rowp + bj * HALF) = w;
                    if (u.pn == 11 && bj == 0 && wc == 3) *(v4u*)(ik + (size_t)row * 32 + 8 * fq) = w;
                    if (u.pn == 11 && bj == 1 && wc == 0 && fq < 2) {
                        float* ap = aux + (size_t)row * 16 + 8 * fq; *(f32x4*)ap = v0; *(f32x4*)(ap + 4) = v1; } }
                asm volatile("" ::: "memory"); __builtin_amdgcn_sched_barrier(0); }
    }
};
struct EpiOut {
    static constexpr bool COL16 = false;
    const bf16* xb; bf16* y1;
    __device__ __forceinline__ void operator()(const f32x4 (&acc)[2][2][4][2], const Unit& u, LAS int*, int wr, int wc, int fr, int fq) const {
        const int row0 = u.pm * BM + wr * 64 + fr, col0 = u.pn * BM + wc * 32 + 8 * fq;
#pragma unroll
        for (int ai = 0; ai < 2; ++ai) {
            v4u xv[4][2];
#pragma unroll
            for (int m = 0; m < 4; ++m)
#pragma unroll
                for (int bj = 0; bj < 2; ++bj) xv[m][bj] = *(const v4u*)(xb + (size_t)(row0 + ai * HALF + m * 16) * DM + col0 + bj * HALF);
#pragma unroll
            for (int m = 0; m < 4; ++m) { const size_t off = (size_t)(row0 + ai * HALF + m * 16) * DM + col0;
#pragma unroll
                for (int bj = 0; bj < 2; ++bj) { const v4u xq = xv[m][bj]; const f32x4 v0 = acc[ai][bj][m][0], v1 = acc[ai][bj][m][1];
                    v4u w; w.x = cvt_pk_bf16(v0[0] + ALPHA * bflo(xq.x), v0[1] + ALPHA * bfhi(xq.x)); w.y = cvt_pk_bf16(v0[2] + ALPHA * bflo(xq.y), v0[3] + ALPHA * bfhi(xq.y));
                    w.z = cvt_pk_bf16(v1[0] + ALPHA * bflo(xq.z), v1[1] + ALPHA * bfhi(xq.z)); w.w = cvt_pk_bf16(v1[2] + ALPHA * bflo(xq.w), v1[3] + ALPHA * bfhi(xq.w));
                    *(v4u*)(y1 + off + bj * HALF) = w; }
                asm volatile("" ::: "memory"); __builtin_amdgcn_sched_barrier(0); }
        }
    }
};
template <int MODE> struct EpiGU {
    static constexpr bool COL16 = false;
    const GroupedOrder<MODE>& S; bf16* abuf; const float* gate;
    __device__ __forceinline__ void operator()(const f32x4 (&acc)[2][2][4][2], const Unit& u, LAS int* lst, int wr, int wc, int fr, int fq) const {
        const int col0 = u.pn * HALF + wc * 32 + 8 * fq;
#pragma unroll
        for (int ai = 0; ai < 2; ++ai)
#pragma unroll
            for (int m = 0; m < 4; ++m) { const int row = ai * HALF + wr * 64 + m * 16 + fr; const int r = u.pm * BM + row;
                if (r < u.cnt) {
                    float o[8];
#pragma unroll
                    for (int n = 0; n < 2; ++n)
#pragma unroll
                        for (int j = 0; j < 4; ++j) { const float g = acc[ai][0][m][n][j], up = acc[ai][1][m][n][j]; const float sg = g * __builtin_amdgcn_rcpf(1.0f + __builtin_amdgcn_exp2f(-g * LOG2E)); o[4 * n + j] = sg * up; }
                    v4u w; w.x = cvt_pk_bf16(o[0], o[1]); w.y = cvt_pk_bf16(o[2], o[3]); w.z = cvt_pk_bf16(o[4], o[5]); w.w = cvt_pk_bf16(o[6], o[7]);
                    *(v4u*)(abuf + (size_t)(u.sb + row) * DEXP + col0) = w; }
                asm volatile("" ::: "memory"); __builtin_amdgcn_sched_barrier(0); }
    }
};
template <int MODE> struct EpiDown {
    static constexpr bool COL16 = true;
    const GroupedOrder<MODE>& S; bf16* ybuf; int nostore;
    __device__ __forceinline__ void operator()(const f32x4 (&acc)[2][2][4][2], const Unit& u, LAS int*, int wr, int wc, int fr, int fq) const {
        const int col0 = u.pn * BM + wc * 32 + 8 * fq; (void)col0;
#pragma unroll
        for (int ai = 0; ai < 2; ++ai)
#pragma unroll
            for (int m = 0; m < 4; ++m) { const int row = ai * HALF + wr * 64 + m * 16 + fr;
#if YFP8
                unsigned char* rowp = (unsigned char*)ybuf + (size_t)(u.sb + row) * DM + u.pn * BM + wc * 64 + 16 * fq;
#define Y8(x) __builtin_amdgcn_fmed3f((x) * YSCALE, -448.f, 448.f)
                int wv[4];
#pragma unroll
                for (int bj = 0; bj < 2; ++bj) { const f32x4 v0 = acc[ai][bj][m][0], v1 = acc[ai][bj][m][1];
                    int w0 = 0, w1 = 0;
                    w0 = __builtin_amdgcn_cvt_pk_fp8_f32(Y8(v0[0]), Y8(v0[1]), w0, false); w0 = __builtin_amdgcn_cvt_pk_fp8_f32(Y8(v0[2]), Y8(v0[3]), w0, true);
                    w1 = __builtin_amdgcn_cvt_pk_fp8_f32(Y8(v1[0]), Y8(v1[1]), w1, false); w1 = __builtin_amdgcn_cvt_pk_fp8_f32(Y8(v1[2]), Y8(v1[3]), w1, true);
                    wv[2 * bj] = w0; wv[2 * bj + 1] = w1; }
#undef Y8
                { v4u w; w.x = (unsigned)wv[0]; w.y = (unsigned)wv[1]; w.z = (unsigned)wv[2]; w.w = (unsigned)wv[3];
                  if (!nostore) __builtin_nontemporal_store(w, (v4u*)rowp); else asm volatile("" :: "v"(w)); }
#else
                bf16* rowp = ybuf + (size_t)(u.sb + row) * DM + u.pn * BM + wc * 64 + 16 * fq;
#pragma unroll
                for (int bj = 0; bj < 2; ++bj) { const f32x4 v0 = acc[ai][bj][m][0], v1 = acc[ai][bj][m][1];
                    v4u w; w.x = cvt_pk_bf16(v0[0], v0[1]); w.y = cvt_pk_bf16(v0[2], v0[3]); w.z = cvt_pk_bf16(v1[0], v1[1]); w.w = cvt_pk_bf16(v1[2], v1[3]);
                    if (!nostore) __builtin_nontemporal_store(w, (v4u*)(rowp + 8 * bj)); else asm volatile("" :: "v"(w)); }
#endif
                asm volatile("" ::: "memory"); __builtin_amdgcn_sched_barrier(0); }
    }
};
}
struct Args { const float* in[20]; float* out; unsigned char* ws; int ph_lo, ph_hi, rep, pad; };
struct Frame {
    LAS unsigned char* lds;
    volatile LAS unsigned* MISC;
    gu32* ctl;
    int tid, lane, wave, wave0, G, vcu, G0, vcu0;
    GAS unsigned char* ws; GAS unsigned char* ws0;
};
#define WSP(T, off) ((T*)(GAS T*)(F.ws + (off)))
#define UNIT_BEGIN() do { F.lane = lane_id_now(); F.wave = F.wave0; F.tid = F.wave0 * 64 + F.lane; { GAS unsigned char* w_ = F.ws0; asm volatile("" : "+s"(w_)); F.ws = w_; int g_ = F.G0, v_ = F.vcu0; asm volatile("" : "+s"(g_), "+s"(v_)); F.G = g_; F.vcu = v_; } } while (0)

__device__ __forceinline__ int win_srccol(int n) {
    if (n < 768) return n;
    if (n < 1536) return 772 + (n - 768);
    if (n < 2304) return 2188 + (n - 1536);
    if (n < 2560) return 1540 + (n - 2304);
    if (n < 2752) return 1836 + (n - 2560);
    if (n < 2880) return 2028 + (n - 2752);
    if (n < 2912) return 2156 + (n - 2880);
    if (n < 2944) return 1796 + (n - 2912);
    if (n < 2952) return 1828 + (n - 2944);
    if (n < 2956) return 768 + (n - 2952);
    return -1;
}
__device__ __forceinline__ float win_scale(int n) { return ((n < 256) || (n >= 768 && n < 1024) || (n >= 1536 && n < 1792)) ? QSCALE64 : 1.0f; }

template <int MODE>
__device__ __forceinline__ void cvt_item(const float* W, int ldw, bf16* WT, bf16* WT2, int ldt, int k0, int n0, const float* kvec, float sc, LAS float* scr, int lane) {
    const int nl = lane & 31, n = n0 + nl;
    int col = n; float s = 1.0f;
    if (MODE == 1) { col = win_srccol(n); s = win_scale(n); }
    if (MODE == 2) { const int pn = n >> 8, j = n & 255; col = (j < 128) ? (128 * pn + j) : (256 + 128 * pn + (j - 128)); }
#pragma unroll
    for (int i = 0; i < 32; ++i) { const int kk = 2 * i + (lane >> 5); float v = (col >= 0) ? __builtin_nontemporal_load(W + (size_t)(k0 + kk) * ldw + col) : 0.0f;
        if (MODE == 1) v *= s;
        if (MODE == 3) v *= kvec[k0 + kk] * sc;
        scr[kk * 33 + nl] = v; }
    LDS_WAIT(); asm volatile("" ::: "memory");
    const int c = lane & 7;
#pragma unroll
    for (int j = 0; j < 4; ++j) { const int nn = (lane >> 3) + 8 * j; const LAS float* sp = scr + (8 * c) * 33 + nn;
        float v[8];
#pragma unroll
        for (int q = 0; q < 8; ++q) v[q] = sp[q * 33];
        v4u o; o.x = pk2(v[0], v[1]); o.y = pk2(v[2], v[3]); o.z = pk2(v[4], v[5]); o.w = pk2(v[6], v[7]);
        if (MODE == 3) *(GAS v4u*)(WT + ((size_t)((k0 >> 3) + c) * ldt + (n0 + nn)) * 8) = o;
        else __builtin_nontemporal_store(o, (GAS v4u*)(WT + (size_t)(n0 + nn) * ldt + k0 + 8 * c));
        if (MODE == 4) {
            float r[8];
#pragma unroll
            for (int q = 0; q < 8; ++q) r[q] = v[q] - bf2f(f2bf(v[q]));
            v4u o2; o2.x = pk2(r[0], r[1]); o2.y = pk2(r[2], r[3]); o2.z = pk2(r[4], r[5]); o2.w = pk2(r[6], r[7]);
            *(GAS v4u*)(WT2 + (size_t)(n0 + nn) * ldt + k0 + 8 * c) = o2; } }
    LDS_WAIT(); asm volatile("" ::: "memory");
}

__device__ __forceinline__ void p0_prologue(Frame& F, const Args& A) {
    LAS float* scr = (LAS float*)(F.lds + F.wave * 16384);
    const int gw = F.vcu * 8 + F.wave, NGW = F.G * 8;
    constexpr int I0 = 4 * 16 * 96, I1 = 4 * 16 * 32, I2 = 256 * 256, I3 = 4 * 256, I4 = 256 * 128, I5 = 4 * 128, I6 = 4 * 36, I7 = 4 * 32, I8 = 4 * 32;
    constexpr int NITEMS = I0 + I1 + I2 + I3 + I4 + I5 + I6 + I7 + I8;
    for (int it = gw; it < NITEMS; it += NGW) {
        int r = it;
        if (r < I0) { const int l = r / 1536, q = r % 1536, kb = q / 96, nb = q % 96;
            cvt_item<1>(A.in[1] + (size_t)l * 1024 * 2956, 2956, WSP(bf16, WS_WIN) + (size_t)l * NPROJ * 1024, nullptr, 1024, 64 * kb, 32 * nb, nullptr, 1.f, scr, F.lane); continue; } r -= I0;
        if (r < I1) { const int l = r / 512, q = r % 512, kb = q / 32, nb = q % 32;
            cvt_item<0>(A.in[9] + (size_t)l * 1024 * 1024, 1024, WSP(bf16, WS_WOUT) + (size_t)l * 1024 * 1024, nullptr, 1024, 64 * kb, 32 * nb, nullptr, 1.f, scr, F.lane); continue; } r -= I1;
        if (r < I2) { const int le = r / 256, q = r % 256, kb = q / 16, nb = q % 16, l = le >> 6, e = le & 63;
            cvt_item<2>(A.in[14] + (size_t)le * 1024 * 512, 512, WSP(bf16, WS_WGU) + ((size_t)l * 65 + e) * 512 * 1024, nullptr, 1024, 64 * kb, 32 * nb, nullptr, 1.f, scr, F.lane); continue; } r -= I2;
        if (r < I3) { const int l = r / 256, q = r % 256, kb = q / 16, nb = q % 16;
            cvt_item<2>(A.in[16] + (size_t)l * 1024 * 512, 512, WSP(bf16, WS_WGU) + ((size_t)l * 65 + 64) * 512 * 1024, nullptr, 1024, 64 * kb, 32 * nb, nullptr, 1.f, scr, F.lane); continue; } r -= I3;
        if (r < I4) { const int le = r / 128, q = r % 128, kb = q / 32, nb = q % 32, l = le >> 6, e = le & 63;
            cvt_item<0>(A.in[15] + (size_t)le * 256 * 1024, 1024, WSP(bf16, WS_WDN) + ((size_t)l * 65 + e) * 1024 * 256, nullptr, 256, 64 * kb, 32 * nb, nullptr, 1.f, scr, F.lane); continue; } r -= I4;
        if (r < I5) { const int l = r / 128, q = r % 128, kb = q / 32, nb = q % 32;
            cvt_item<0>(A.in[17] + (size_t)l * 256 * 1024, 1024, WSP(bf16, WS_WDN) + ((size_t)l * 65 + 64) * 1024 * 256, nullptr, 256, 64 * kb, 32 * nb, nullptr, 1.f, scr, F.lane); continue; } r -= I5;
        if (r < I6) { const int l = r / 36, q = r % 36, kb = q / 12, nb = q % 12;
            cvt_item<3>(A.in[5] + (size_t)l * 192 * 384, 384, WSP(bf16, WS_WUQ) + (size_t)l * 384 * 192, nullptr, 384, 64 * kb, 32 * nb, A.in[3] + l * 192, QSCALE96, scr, F.lane); continue; } r -= I6;
        if (r < I7) { const int l = r / 32, q = r % 32, kb = q / 16, nb = q % 16;
            cvt_item<3>(A.in[6] + (size_t)l * 128 * 512, 512, WSP(bf16, WS_WUKV) + (size_t)l * 512 * 128, nullptr, 512, 64 * kb, 32 * nb, A.in[4] + l * 128, 1.0f, scr, F.lane); continue; } r -= I7;
        { const int l = r / 32, q = r % 32, kb = q / 2, nb = q % 2;
            cvt_item<4>(A.in[12] + (size_t)l * 1024 * 64, 64, WSP(bf16, WS_WRH) + (size_t)l * 64 * 1024, WSP(bf16, WS_WRL) + (size_t)l * 64 * 1024, 1024, 64 * kb, 32 * nb, nullptr, 1.f, scr, F.lane); }
    }
    bf16* xb = WSP(bf16, WS_XB);
    for (int m = gw; m < NT; m += 2 * NGW) {
        const GAS f32x4* xr = (const GAS f32x4*)(A.in[0] + (size_t)m * DM) + 2 * F.lane; const GAS f32x4* xr2 = (const GAS f32x4*)(A.in[0] + (size_t)(m + NGW) * DM) + 2 * F.lane;
        GAS v4u* o8 = (GAS v4u*)(xb + (size_t)m * DM) + F.lane; GAS v4u* o82 = (GAS v4u*)(xb + (size_t)(m + NGW) * DM) + F.lane;
        f32x4 v[8];
#pragma unroll
        for (int j = 0; j < 2; ++j) { v[2 * j] = __builtin_nontemporal_load(xr + 128 * j); v[2 * j + 1] = __builtin_nontemporal_load(xr + 128 * j + 1); v[4 + 2 * j] = __builtin_nontemporal_load(xr2 + 128 * j); v[5 + 2 * j] = __builtin_nontemporal_load(xr2 + 128 * j + 1); }
#pragma unroll
        for (int j = 0; j < 2; ++j) { v4u o; o.x = pk2(v[2 * j].x, v[2 * j].y); o.y = pk2(v[2 * j].z, v[2 * j].w); o.z = pk2(v[2 * j + 1].x, v[2 * j + 1].y); o.w = pk2(v[2 * j + 1].z, v[2 * j + 1].w); o8[64 * j] = o;
            v4u o2; o2.x = pk2(v[4 + 2 * j].x, v[4 + 2 * j].y); o2.y = pk2(v[4 + 2 * j].z, v[4 + 2 * j].w); o2.z = pk2(v[5 + 2 * j].x, v[5 + 2 * j].y); o2.w = pk2(v[5 + 2 * j].z, v[5 + 2 * j].w); o82[64 * j] = o2; }
    }
}
__device__ __forceinline__ int crow(int r, int hi) { return (r & 3) + 8 * (r >> 2) + 4 * hi; }
__device__ __forceinline__ unsigned tokey(float f) { unsigned u = __builtin_bit_cast(unsigned, f); if (u == 0x80000000u) u = 0u; return u ^ ((u >> 31) ? 0xffffffffu : 0x80000000u); }
__device__ __forceinline__ int half_sum(int v) {
    v += __builtin_amdgcn_update_dpp(0, v, 0xB1, 0xF, 0xF, true);
    v += __builtin_amdgcn_update_dpp(0, v, 0x4E, 0xF, 0xF, true);
    v += __builtin_amdgcn_update_dpp(0, v, 0x141, 0xF, 0xF, true);
    v += __builtin_amdgcn_update_dpp(0, v, 0x140, 0xF, 0xF, true);
    auto rr = __builtin_amdgcn_permlane16_swap((unsigned)v, (unsigned)v, false, false); const unsigned a_ = rr[0], b_ = rr[1];
    return (int)(a_ + b_);
}

constexpr int TK_LOWBIT = 12; constexpr unsigned TK_KEYMASK = ~((1u << TK_LOWBIT) - 1u);
struct TkPre { bf16x8 a0; f32x4 wq; };
__device__ __forceinline__ void topk_operands(Frame& F, int b, int c, int quarter, TkPre& P) {
    const int lane = lane_id_now(), g = lane >> 4, i16 = lane & 15, q0 = 64 * c + 16 * quarter + 2 * F.wave0; const size_t tokb = (size_t)b * SEQ;
    P.a0 = *(const bf16x8*)(WSP(bf16, WS_PROJ) + (tokb + q0 + (i16 >> 3)) * NPROJ + PC_IQ + (i16 & 7) * 32 + 8 * g);
    P.wq = *(const f32x4*)(WSP(float, WS_AUX) + (tokb + q0 + (g >> 1)) * 16 + 4 * (g & 1));
}
template <int NP>
__device__ __forceinline__ void topk_unit(Frame& F, int b, int c, int quarter, bool stage, bool havepre, int cnext, TkPre& io) {
    UNIT_BEGIN();
    const int lane = F.lane, w = F.wave, r32 = lane & 31, hi = lane >> 5, g = lane >> 4, i16 = lane & 15;
    const int np = 2 * (c + 1), q0 = 64 * c + 16 * quarter + 2 * w;
    const bf16* proj = WSP(bf16, WS_PROJ); const float* aux = WSP(float, WS_AUX); unsigned* mask32 = WSP(unsigned, WS_MASK);
    const size_t tokb = (size_t)b * SEQ;
    LAS unsigned char* kl = F.lds + 6144; constexpr int N16 = 512 * 64;
    if (stage) { const bf16* ik = WSP(bf16, WS_IK) + tokb * 32;
      for (int blk = w; blk < (np >> 1); blk += 8) { const int k0 = blk * 64;
#pragma unroll
          for (int ch = 0; ch < 4; ++ch)
              __builtin_amdgcn_global_load_lds((const unsigned*)(ik + (size_t)(k0 + lane) * 32 + ch * 8), (LAS unsigned*)(kl + ch * N16 + k0 * 16), 16, 0, 0); } }
    if (!havepre) topk_operands(F, b, c, quarter, io);
    const bf16x8 a0 = io.a0;
    const f32x4 wq = io.wq * 0.0625f;
    if (stage || !havepre) { VM_WAIT(); __syncthreads(); }
    unsigned key[NP];
    const LAS unsigned char* kp = kl + g * N16 + i16 * 16;
    int np_v = np; asm volatile("" : "+v"(np_v));
#define TK_RELU(x) __builtin_amdgcn_fmed3f((x), 0.f, __builtin_inff())
#define TK_SCORE(dA, dB, OUT) do { \
        float eA_ = TK_RELU(dA[0]) * wq[0]; asm volatile("" : "+v"(eA_)); eA_ = fmaf(TK_RELU(dA[1]), wq[1], eA_); asm volatile("" : "+v"(eA_)); eA_ = fmaf(TK_RELU(dA[2]), wq[2], eA_); asm volatile("" : "+v"(eA_)); eA_ = fmaf(TK_RELU(dA[3]), wq[3], eA_); asm volatile("" : "+v"(eA_)); \
        float eB_ = TK_RELU(dB[0]) * wq[0]; asm volatile("" : "+v"(eB_)); eB_ = fmaf(TK_RELU(dB[1]), wq[1], eB_); asm volatile("" : "+v"(eB_)); eB_ = fmaf(TK_RELU(dB[2]), wq[2], eB_); asm volatile("" : "+v"(eB_)); eB_ = fmaf(TK_RELU(dB[3]), wq[3], eB_); asm volatile("" : "+v"(eB_)); \
        auto rr_ = __builtin_amdgcn_permlane16_swap(__builtin_bit_cast(unsigned, eA_), __builtin_bit_cast(unsigned, eB_), false, false); const unsigned ra_ = rr_[0], rb_ = rr_[1]; \
        float sc_ = __uint_as_float(ra_) + __uint_as_float(rb_); asm volatile("" : "+v"(sc_)); OUT = sc_; } while (0)
#pragma unroll
    for (int p = 0; p < NP; p += 2) {
        const bf16x8 kA0 = *(const LAS bf16x8*)(kp + p * 512), kB0 = *(const LAS bf16x8*)(kp + p * 512 + 256), kA1 = *(const LAS bf16x8*)(kp + p * 512 + 512), kB1 = *(const LAS bf16x8*)(kp + p * 512 + 768);
        const f32x4 z4 = {0.f, 0.f, 0.f, 0.f};
        const f32x4 dA0 = __builtin_amdgcn_mfma_f32_16x16x32_bf16(a0, kA0, z4, 0, 0, 0), dB0 = __builtin_amdgcn_mfma_f32_16x16x32_bf16(a0, kB0, z4, 0, 0, 0);
        const f32x4 dA1 = __builtin_amdgcn_mfma_f32_16x16x32_bf16(a0, kA1, z4, 0, 0, 0), dB1 = __builtin_amdgcn_mfma_f32_16x16x32_bf16(a0, kB1, z4, 0, 0, 0);
        float s0, s1; TK_SCORE(dA0, dB0, s0); TK_SCORE(dA1, dB1, s1);
        key[p] = (p < np_v) ? (tokey(s0) & TK_KEYMASK) : 0u; key[p + 1] = (p + 1 < np_v) ? (tokey(s1) & TK_KEYMASK) : 0u;
        if ((p & 2) == 2) __builtin_amdgcn_sched_barrier(0);
    }
#undef TK_SCORE
#undef TK_RELU
    if (cnext >= 0) topk_operands(F, b, cnext, quarter, io);
    unsigned prefix = 0u; bool done = false;
    for (int bit = 31; bit >= TK_LOWBIT; --bit) {
        const unsigned cand = prefix | (1u << bit);
        int nn[4] = {0, 0, 0, 0};
#pragma unroll
        for (int p = 0; p < NP; ++p) nn[p & 3] += (key[p] >= cand) ? 1 : 0;
        int n = half_sum((nn[0] + nn[1]) + (nn[2] + nn[3]));
        if (!done) { if (n >= 256) prefix = cand; if (n == 256) done = true; }
        if (__all(done)) break;
    }
    LAS unsigned long long* wm = (LAS unsigned long long*)(F.lds + 1536 + w * 512);
    int cge = 0;
#pragma unroll
    for (int p = 0; p < NP; ++p) { const bool ge = key[p] >= prefix; cge += ge ? 1 : 0; wm[p] = __ballot(ge); if ((p & 7) == 7) __builtin_amdgcn_sched_barrier(0); }
    cge = half_sum(cge);
    if (!__all(cge == 256)) {
        int gtc = 0;
#pragma unroll
        for (int p = 0; p < NP; ++p) gtc += (key[p] > prefix) ? 1 : 0;
        gtc = half_sum(gtc);
        const int need = 256 - gtc; int run = 0; const unsigned below = (1u << r32) - 1u;
#pragma unroll
        for (int p = 0; p < NP; ++p) {
            const bool eq = key[p] == prefix, gt = key[p] > prefix;
            const unsigned long long be = __ballot(eq);
            const unsigned m32 = hi ? (unsigned)(be >> 32) : (unsigned)be;
            const int rank = __popc(m32 & below);
            const bool sel = gt || (eq && (run + rank < need));
            run += __popc(m32);
            wm[p] = __ballot(sel);
        }
    }
    LDS_WAIT();
    {
        const LAS unsigned* wm32 = (const LAS unsigned*)wm;
        if (lane < np) { mask32[(tokb + q0) * 64 + lane] = wm32[lane * 2]; mask32[(tokb + q0 + 1) * 64 + lane] = wm32[lane * 2 + 1]; }
    }
}

__device__ __forceinline__ void mla_stage(LAS unsigned char* lds, const bf16* W, int N, int K, int kchunk0, int nchunks, int w, int lane) {
    const int nb = N >> 6;
    for (int it = w; it < nchunks * nb; it += 8) { const int ch = it / nb, b64 = it % nb;
        __builtin_amdgcn_global_load_lds((const unsigned*)(W + ((size_t)(kchunk0 + ch) * N + b64 * 64 + lane) * 8), (LAS unsigned*)(lds + ch * (N * 16) + b64 * 1024), 16, 0, 0); }
}
template <int NC> __device__ __forceinline__ void mla_flush(LAS unsigned char* st, bf16* gdst  , int gpitch  , int lane_unused) {
    constexpr int PITCH = NC * 2 + 16, L16 = NC / 8, NJ = 32 * L16 / 64;
    (void)lane_unused;
    LDS_WAIT();
    const int lane = lane_id_now();
#pragma unroll
    for (int j0 = 0; j0 < NJ; j0 += 4) {
        v4u t[4];
#pragma unroll
        for (int j = 0; j < 4; ++j) { const int i = lane + 64 * (j0 + j), row = i / L16, pc = i % L16; t[j] = *(const LAS v4u*)(st + row * PITCH + pc * 16); }
#pragma unroll
        for (int j = 0; j < 4; ++j) { const int i = lane + 64 * (j0 + j), row = i / L16, pc = i % L16; const unsigned off = (unsigned)(row * gpitch + pc * 8); *(v4u*)(gdst + off) = t[j]; }
        __builtin_amdgcn_sched_barrier(0);
    }
    LDS_WAIT();
}
__device__ __forceinline__ void mla_unit(Frame& F, const Args& A, int layer, int unit) {
    UNIT_BEGIN();
    const int lane = F.lane, w = F.wave, r32 = lane & 31, hi = lane >> 5, rt = w & 3, nh = w >> 2;
    const int tok0 = unit * 128 + rt * 32, tok = tok0 + r32, pos = tok & (SEQ - 1);
    const bf16* proj = WSP(bf16, WS_PROJ); bf16* qm = WSP(bf16, WS_QMLA); bf16* km = WSP(bf16, WS_KMLA); bf16* vm = WSP(bf16, WS_VMLA);
    const bf16* wq = WSP(bf16, WS_WUQ) + (size_t)layer * 384 * 192; const bf16* wkv = WSP(bf16, WS_WUKV) + (size_t)layer * 512 * 128;
    const bf16* prow = proj + (size_t)tok * NPROJ;
    LAS unsigned char* lds = F.lds;
    LAS unsigned char* st = lds + w * 12800;
    __syncthreads();
    mla_stage(lds, wq, 384, 192, 0, 12, w, lane);
    float sq = 0.f, skv = 0.f;
    float cs[8], sn[8];
#pragma unroll
    for (int r = 0; r < 8; ++r) { const int i = crow(r, hi); const float inv = exp2f(-(float)i * (13.287712379549449f / 16.0f)); const float ang = (float)pos * inv;
        float rev = ang * 0.15915494309189535f; rev = rev - floorf(rev); sn[r] = __builtin_amdgcn_sinf(rev); cs[r] = __builtin_amdgcn_cosf(rev); }
    {
    bf16x8 bq[12];
#pragma unroll
    for (int kk = 0; kk < 12; ++kk) { bq[kk] = *(const bf16x8*)(prow + PC_CQ + 16 * kk + 8 * hi);
#pragma unroll
        for (int e = 0; e < 8; ++e) { const float v = bf2f((unsigned short)bq[kk][e]); sq += v * v; } }
    const float rq = rsqrtf(swap32_add(sq) * (1.0f / 192.0f) + RMS_EPS);
    f32x16 acc[6];
#pragma unroll
    for (int t = 0; t < 6; ++t) acc[t] = f32x16{};
#pragma unroll
    for (int stg = 0; stg < 2; ++stg) {
        VM_WAIT(); __syncthreads();
#pragma unroll
        for (int t = 0; t < 6; ++t) {
            const LAS unsigned char* wp = lds + hi * (384 * 16) + (32 * (6 * nh + t) + r32) * 16;
#pragma unroll
            for (int kk = 0; kk < 6; ++kk) { const bf16x8 a = *(const LAS bf16x8*)(wp + (2 * kk) * (384 * 16)); acc[t] = __builtin_amdgcn_mfma_f32_32x32x16_bf16(a, bq[6 * stg + kk], acc[t], 0, 0, 0); }
        }
        __syncthreads();
        if (stg == 0) mla_stage(lds, wq, 384, 192, 12, 12, w, lane);
    }
#ifdef MLA_PROBE_CUT
    if (A.rep && MLA_PROBE_CUT <= 1) { __syncthreads(); return; }
#endif
#pragma unroll
    for (int t = 0; t < 6; ++t) {
        float o[16];
#pragma unroll
        for (int r = 0; r < 16; ++r) o[r] = acc[t][r] * rq;
        if (t % 3 == 2) {
#pragma unroll
            for (int r = 0; r < 8; ++r) { const float x1 = o[r], x2 = o[r + 8]; o[r] = x1 * cs[r] - x2 * sn[r]; o[r + 8] = x2 * cs[r] + x1 * sn[r]; }
        }
#pragma unroll
        for (int g = 0; g < 4; ++g) { v2u w2; w2.x = cvt_pk_bf16(o[4 * g], o[4 * g + 1]); w2.y = cvt_pk_bf16(o[4 * g + 2], o[4 * g + 3]); *(LAS v2u*)(st + r32 * 400 + (32 * t + 8 * g + 4 * hi) * 2) = w2; }
    }
    mla_flush<192>(st, qm + (size_t)tok0 * 384 + 192 * nh, 384, lane);
    }
    __syncthreads();
#ifdef MLA_PROBE_CUT
    if (A.rep && MLA_PROBE_CUT <= 2) return;
#endif
    mla_stage(lds, wkv, 512, 128, 0, 16, w, lane);
    {
    float kr[16];
#pragma unroll
    for (int g = 0; g < 4; ++g) { const v2u w2 = *(const v2u*)(prow + PC_KR + 8 * g + 4 * hi); kr[4 * g] = bflo(w2.x); kr[4 * g + 1] = bfhi(w2.x); kr[4 * g + 2] = bflo(w2.y); kr[4 * g + 3] = bfhi(w2.y); }
    v2u krp[4];
    { float kro[16];
#pragma unroll
      for (int r = 0; r < 8; ++r) { kro[r] = kr[r] * cs[r] - kr[r + 8] * sn[r]; kro[r + 8] = kr[r + 8] * cs[r] + kr[r] * sn[r]; }
#pragma unroll
      for (int g = 0; g < 4; ++g) { krp[g].x = cvt_pk_bf16(kro[4 * g], kro[4 * g + 1]); krp[g].y = cvt_pk_bf16(kro[4 * g + 2], kro[4 * g + 3]); } }
    bf16x8 bkv[8];
#pragma unroll
    for (int kk = 0; kk < 8; ++kk) { bkv[kk] = *(const bf16x8*)(prow + PC_CKV + 16 * kk + 8 * hi);
#pragma unroll
        for (int e = 0; e < 8; ++e) { const float v = bf2f((unsigned short)bkv[kk][e]); skv += v * v; } }
    const float rkv = rsqrtf(swap32_add(skv) * (1.0f / 128.0f) + RMS_EPS);
    VM_WAIT(); __syncthreads();
    v2u res[2][4][4];
#pragma unroll
    for (int hh2 = 0; hh2 < 2; ++hh2) {
        const int hh = 2 * nh + hh2;
#pragma unroll
        for (int j = 0; j < 4; ++j) {
            f32x16 acc = {};
            const LAS unsigned char* wp = lds + hi * (512 * 16) + (32 * (4 * hh + j) + r32) * 16;
#pragma unroll
            for (int kk = 0; kk < 8; ++kk) { const bf16x8 a = *(const LAS bf16x8*)(wp + (2 * kk) * (512 * 16)); acc = __builtin_amdgcn_mfma_f32_32x32x16_bf16(a, bkv[kk], acc, 0, 0, 0); }
#pragma unroll
            for (int g = 0; g < 4; ++g) { res[hh2][j][g].x = cvt_pk_bf16(acc[4 * g] * rkv, acc[4 * g + 1] * rkv); res[hh2][j][g].y = cvt_pk_bf16(acc[4 * g + 2] * rkv, acc[4 * g + 3] * rkv); }
        }
        __builtin_amdgcn_sched_barrier(0);
    }
    __syncthreads();
#ifdef MLA_PROBE_CUT
    if (A.rep && MLA_PROBE_CUT <= 3) return;
#endif
#pragma unroll
    for (int hh2 = 0; hh2 < 2; ++hh2) {
#pragma unroll
        for (int j = 0; j < 2; ++j)
#pragma unroll
            for (int g = 0; g < 4; ++g) *(LAS v2u*)(st + r32 * 400 + (96 * hh2 + 32 * j + 8 * g + 4 * hi) * 2) = res[hh2][j][g];
#pragma unroll
        for (int g = 0; g < 4; ++g) *(LAS v2u*)(st + r32 * 400 + (96 * hh2 + 64 + 8 * g + 4 * hi) * 2) = krp[g];
    }
    mla_flush<192>(st, km + (size_t)tok0 * 384 + 192 * nh, 384, lane);
#pragma unroll
    for (int hh2 = 0; hh2 < 2; ++hh2)
#pragma unroll
        for (int j = 0; j < 2; ++j)
#pragma unroll
            for (int g = 0; g < 4; ++g) *(LAS v2u*)(st + r32 * 272 + (64 * hh2 + 32 * j + 8 * g + 4 * hi) * 2) = res[hh2][2 + j][g];
    mla_flush<128>(st, vm + (size_t)tok0 * 256 + 128 * nh, 256, lane);
    }
    __syncthreads();
}

__device__ __forceinline__ void cum_unit(Frame& F, const Args& A, int layer, int unit) {
    UNIT_BEGIN();
    const int b = unit >> 2, h = unit & 3, t = F.tid;
    const float* aux = WSP(float, WS_AUX); float* cum = WSP(float, WS_CUM);
    LAS float* wtot = (LAS float*)(F.lds);
    const float bf = A.in[2][layer * 4 + h];
    float v[4]; float run = 0.f;
#pragma unroll
    for (int i = 0; i < 4; ++i) { const float z = aux[((size_t)b * SEQ + 4 * t + i) * 16 + 8 + h] + bf; const float ls = fminf(z, 0.f) - log1pf(expf(-fabsf(z))); run += ls; v[i] = run; }
    float inc = 0.f;
#pragma unroll
    for (int j = 0; j < 64; ++j) { const float vj = __builtin_bit_cast(float, __builtin_amdgcn_readlane(__builtin_bit_cast(int, run), j)); inc += (j <= F.lane) ? vj : 0.f; }
    if (F.lane == 63) wtot[F.wave] = inc;
    __syncthreads();
    float base = inc - run;
    for (int w = 0; w < F.wave; ++w) base += wtot[w];
    f32x4 o4; o4.x = (base + v[0]) * LOG2E; o4.y = (base + v[1]) * LOG2E; o4.z = (base + v[2]) * LOG2E; o4.w = (base + v[3]) * LOG2E;
    *(f32x4*)(cum + ((size_t)(b * 4 + h)) * SEQ + 4 * t) = o4;
    __syncthreads();
}

__device__ __forceinline__ void knorm_jobs(Frame& F) {
    UNIT_BEGIN();
    float* kn = WSP(float, WS_KNORM);
    for (int job = F.vcu * 8 + F.wave; job < 64 * 32; job += F.G * 8) {
        const int bh = job >> 5, tile = job & 31, b = bh >> 2, h = bh & 3;
        const v4u* kp = (const v4u*)(WSP(bf16, WS_PROJ) + ((size_t)b * SEQ + 64 * tile + F.lane) * NPROJ + PC_FOX + 256 + h * 64);
        float ss = 0.f;
#pragma unroll
        for (int c = 0; c < 8; ++c) { const v4u v = kp[c];
#pragma unroll
            for (int j = 0; j < 4; ++j) { const unsigned w_ = v[j]; const float lo = __uint_as_float(w_ << 16), hi_ = __uint_as_float(w_ & 0xffff0000u); ss += lo * lo + hi_ * hi_; } }
        const float m = wave_max_nn(ss);
        if (F.lane == 0) kn[bh * 64 + tile] = sqrtf(m) * 1.002f;
    }
}
constexpr int AT_K = 0, AT_V = 36864, AT_TAB = 61440, AT_WS = 63488, AT_MASK = 65536, AT_CUM = 65536, AT_END = AT_MASK + 256 * 264;
static_assert(AT_END <= MISC_OFF, "attention LDS");
typedef short v4i16_t __attribute__((ext_vector_type(4)));

template <int KIND>
__device__ __forceinline__ void attn_unit(Frame& F, const Args& A, int layer, int b, int h, int qb) {
    UNIT_BEGIN();
    constexpr int DQK = (KIND == 2) ? 96 : 64, NKC = DQK / 8, NKS = DQK / 16;
    constexpr int OFF = (KIND == 1) ? 128 : 256, NTAB = OFF + 64, TPAD = 128;
    const int tid = F.tid, lane = F.lane, wid = F.wave, r32 = lane & 31, hi = lane >> 5;
    LAS unsigned char* lds = F.lds;
    const bf16* proj = WSP(bf16, WS_PROJ);
    const size_t tokb = (size_t)b * SEQ;
    const bf16 *Qg, *Kg, *Vg; int PQ, PK, PV;
    if (KIND == 2) { Qg = WSP(bf16, WS_QMLA) + tokb * 384 + h * 96; Kg = WSP(bf16, WS_KMLA) + tokb * 384 + h * 96; Vg = WSP(bf16, WS_VMLA) + tokb * 256 + h * 64; PQ = 384; PK = 384; PV = 256; }
    else { const int base = (KIND == 0) ? PC_FOX : (KIND == 1) ? PC_DSA : PC_BAND; Qg = proj + tokb * NPROJ + base + h * 64; Kg = Qg + 256; Vg = Qg + 512; PQ = NPROJ; PK = NPROJ; PV = NPROJ; }
    const int mixcol = ((KIND == 0) ? 0 : (KIND == 1) ? 256 : (KIND == 2) ? 512 : 768) + h * 64;
    int t_lo = (KIND == 3) ? ((4 * qb - 8) > 0 ? (4 * qb - 8) : 0) : 0; const int t_hi = 4 * qb + 4;
    const int cw = 4 * qb + (wid >> 1), rsub = 32 * (wid & 1) + r32;
    LAS float* tab = (LAS float*)(lds + AT_TAB); LAS float* ctab = (LAS float*)(lds + AT_CUM); LAS float* wsf = (LAS float*)(lds + AT_WS) + wid * 64;
    float farc = 0.f;
    if (KIND == 1) {
        farc = A.in[7][15 * 4 + h] * LOG2E;
        if (tid < NTAB) { const int rel = tid - OFF, n = rel < 0 ? -rel : rel; int bk; if (n < 8) bk = n; else { bk = 8 + (31 - __clz(n * n)) - 6; bk = bk > 15 ? 15 : bk; } if (rel > 0) bk += 16; tab[TPAD + tid] = A.in[7][bk * 4 + h] * LOG2E; }
        else if (tid < NTAB + TPAD) tab[tid - NTAB] = farc;
        if (qb >= 1) { const v2u* gm = WSP(v2u, WS_MASK) + (tokb + 256 * qb) * 32; LAS v2u* lm = (LAS v2u*)(lds + AT_MASK);
            for (int idx = tid; idx < 256 * 32; idx += 512) { const int row = idx >> 5, T = idx & 31; if (T < t_hi) lm[row * 33 + T] = gm[(size_t)row * 32 + T]; } }
    }
    if (KIND == 3) {
        const float* cr = A.in[8] + (size_t)(layer * 4 + h) * 513;
        farc = cr[512] * LOG2E;
        if (tid < NTAB) { int d = OFF - tid; d = d < -256 ? -256 : (d > 256 ? 256 : d); tab[TPAD + tid] = cr[d + 256] * LOG2E; }
        else if (tid < NTAB + TPAD) tab[tid - NTAB] = farc;
    }
    bf16x8 qr[NKS];
    if (KIND == 0) {
        const float* cu = WSP(float, WS_CUM) + (size_t)(b * 4 + h) * SEQ; const float cref = cu[256 * qb];
        for (int s = tid; s < 256 * qb + 256; s += 512) ctab[s] = cref - cu[s];
        { const bf16* qp = Qg + (size_t)(64 * cw + rsub) * PQ + 8 * hi;
#pragma unroll
          for (int d0 = 0; d0 < NKS; ++d0) qr[d0] = *(const bf16x8*)(qp + 16 * d0); }
        float ss = 0.f;
#pragma unroll
        for (int d0 = 0; d0 < NKS; ++d0) { const v4u qw = __builtin_bit_cast(v4u, qr[d0]);
#pragma unroll
            for (int j = 0; j < 4; ++j) { const unsigned w_ = qw[j]; const float lo = __uint_as_float(w_ << 16), hi_ = __uint_as_float(w_ & 0xffff0000u); ss += lo * lo + hi_ * hi_; } }
        ss = wave_max_nn(swap32_add(ss));
        if (lane == 0) tab[wid] = ss;
        __syncthreads();
        float qm = 0.f;
#pragma unroll
        for (int w = 0; w < 8; ++w) qm = fmaxf(qm, tab[w]);
        qm = sqrtf(qm) * 1.002f;
        const float* kn = WSP(float, WS_KNORM) + (size_t)(b * 4 + h) * 64;
        const float kd = fmaxf(fmaxf(kn[4 * qb], kn[4 * qb + 1]), fmaxf(kn[4 * qb + 2], kn[4 * qb + 3]));
        const float thr = -(qm * kd) - 40.f;
        int tl = 0;
        while (tl < 4 * qb && qm * kn[32 + tl] + ctab[64 * tl + 63] <= thr) ++tl;
        t_lo = __builtin_amdgcn_readfirstlane(tl);
    }
    const bf16* ksrc = Kg + (size_t)lane * PK; const bf16* vsrc = Vg + (size_t)(16 * (wid & 3) + (lane >> 2)) * PV + (wid >> 2) * 32 + (lane & 3) * 8;
#define AT_ISSUE(t, slot) do { \
        _Pragma("unroll") for (int c_ = 0; c_ < 2; ++c_) { const int cc_ = wid + 8 * c_; if (cc_ < NKC) \
            __builtin_amdgcn_global_load_lds((const unsigned*)(ksrc + (size_t)(t) * 64 * PK + cc_ * 8), (LAS unsigned*)(lds + AT_K + (slot) * 12288 + cc_ * 1024), 16, 0, 0); } \
        __builtin_amdgcn_global_load_lds((const unsigned*)(vsrc + (size_t)(t) * 64 * PV), (LAS unsigned*)(lds + AT_V + (slot) * 8192 + wid * 1024), 16, 0, 0); } while (0)
    AT_ISSUE(t_lo, 0);
    if (t_lo + 1 < t_hi) AT_ISSUE(t_lo + 1, 1);
    if (KIND != 0) { const bf16* qp = Qg + (size_t)(64 * cw + rsub) * PQ + 8 * hi;
#pragma unroll
      for (int d0 = 0; d0 < NKS; ++d0) qr[d0] = *(const bf16x8*)(qp + 16 * d0); }
    float m_run = -INFINITY, l_run = 0.f; f32x16 o[2]; o[0] = f32x16{}; o[1] = f32x16{};
    const bool three = (NKC > 8) && (wid + 8 < NKC);
    { const bf16x8 q0_ = qr[0]; asm volatile("" :: "v"(q0_)); }
    if (t_lo + 1 < t_hi) { if (three) asm volatile("s_waitcnt vmcnt(3)" ::: "memory"); else asm volatile("s_waitcnt vmcnt(2)" ::: "memory"); } else VM_WAIT();
    __syncthreads();
    const int vrd0 = ((lane >> 4) & 1) * 32 + (lane & 3) * 8 + (4 * hi + ((lane & 15) >> 2)) * 64;
    int slot = 0;
    for (int t = t_lo; t < t_hi; ++t) {
        if (t + 2 < t_hi) { const int s2 = slot >= 1 ? slot - 1 : 2; AT_ISSUE(t + 2, s2); }
        const bool active = (KIND == 3) ? (t >= cw - 8 && t <= cw) : (t <= cw);
        if (active) {
            const LAS unsigned char* Ks = lds + AT_K + slot * 12288; const LAS unsigned char* Vs = lds + AT_V + slot * 8192;
            f32x16 p0, p1;
            if (KIND == 0) {
#pragma unroll
                for (int g = 0; g < 4; ++g) { const f32x4 a = *(const LAS f32x4*)(ctab + 64 * t + 8 * g + 4 * hi), c = *(const LAS f32x4*)(ctab + 64 * t + 32 + 8 * g + 4 * hi);
                    p0[4 * g] = a.x; p0[4 * g + 1] = a.y; p0[4 * g + 2] = a.z; p0[4 * g + 3] = a.w; p1[4 * g] = c.x; p1[4 * g + 1] = c.y; p1[4 * g + 2] = c.z; p1[4 * g + 3] = c.w; }
            } else { p0 = f32x16{}; p1 = f32x16{}; }
#pragma unroll
            for (int d0 = 0; d0 < NKS; ++d0) { const bf16x8 k0 = *(const LAS bf16x8*)(Ks + (2 * d0 + hi) * 1024 + r32 * 16), k1 = *(const LAS bf16x8*)(Ks + (2 * d0 + hi) * 1024 + r32 * 16 + 512);
                p0 = __builtin_amdgcn_mfma_f32_32x32x16_bf16(k0, qr[d0], p0, 0, 0, 0); p1 = __builtin_amdgcn_mfma_f32_32x32x16_bf16(k1, qr[d0], p1, 0, 0, 0); }
            if (KIND == 1 || KIND == 3) {
                const int maxrel = 64 * (t - cw) + 63 - 32 * (wid & 1);
                if (maxrel <= -OFF) {
                    p0 = p0 + farc; p1 = p1 + farc;
                } else {
                    const LAS float* tb = tab + (TPAD + 64 * (t - cw) - rsub + OFF + 4 * hi);
#pragma unroll
                    for (int r = 0; r < 16; ++r) { p0[r] += tb[(r & 3) + 8 * (r >> 2)]; p1[r] += tb[32 + (r & 3) + 8 * (r >> 2)]; }
                }
            }
            if (KIND == 1) {
                if (qb >= 1) { const v2u mw = ((const LAS v2u*)(lds + AT_MASK))[(64 * (wid >> 1) + rsub) * 33 + t]; const unsigned wl = mw.x >> (4 * hi), wh = mw.y >> (4 * hi);
#pragma unroll
                    for (int r = 0; r < 16; ++r) { const int bit = (r & 3) + 8 * (r >> 2);
                        const unsigned m0_ = (unsigned)__builtin_amdgcn_sbfe((int)wl, bit, 1), m1_ = (unsigned)__builtin_amdgcn_sbfe((int)wh, bit, 1);
                        p0[r] = __uint_as_float((__float_as_uint(p0[r]) & m0_) | (~m0_ & 0xff800000u)); p1[r] = __uint_as_float((__float_as_uint(p1[r]) & m1_) | (~m1_ & 0xff800000u)); } }
            }
            if (KIND == 0) {
                if (t == cw) {
#pragma unroll
                    for (int r = 0; r < 16; ++r) { const int kv = crow(r, hi); if (kv > rsub) p0[r] = -INFINITY; if (kv + 32 > rsub) p1[r] = -INFINITY; } }
            }
            float rm;
            { const f32x16 mx = __builtin_elementwise_max(p0, p1);
              float a_ = fmaxf(fmaxf(mx[0], mx[1]), mx[2]), b_ = fmaxf(fmaxf(mx[3], mx[4]), mx[5]), c_ = fmaxf(fmaxf(mx[6], mx[7]), mx[8]), d_ = fmaxf(fmaxf(mx[9], mx[10]), mx[11]);
              a_ = fmaxf(fmaxf(a_, mx[12]), mx[13]); b_ = fmaxf(fmaxf(b_, mx[14]), mx[15]); rm = fmaxf(fmaxf(a_, b_), fmaxf(c_, d_)); }
            rm = swap32_max(rm);
            const float mnew = fmaxf(m_run, rm), muse = (mnew == -INFINITY) ? 0.f : mnew;
            const float alpha = __builtin_amdgcn_exp2f(m_run - muse);
            p0 = p0 - muse; p1 = p1 - muse;
#pragma unroll
            for (int r = 0; r < 16; ++r) { p0[r] = __builtin_amdgcn_exp2f(p0[r]); p1[r] = __builtin_amdgcn_exp2f(p1[r]); }
            float ps;
            { const f32x16 sv = p0 + p1; const f32x4 s4 = (f32x4){sv[0], sv[1], sv[2], sv[3]} + (f32x4){sv[4], sv[5], sv[6], sv[7]} + (f32x4){sv[8], sv[9], sv[10], sv[11]} + (f32x4){sv[12], sv[13], sv[14], sv[15]}; ps = (s4[0] + s4[1]) + (s4[2] + s4[3]); }
            l_run = l_run * alpha + ps; m_run = mnew;
            if (__any(alpha != 1.0f)) {
                if (hi == 0) wsf[r32] = alpha;
                LDS_WAIT();
                f32x16 av;
#pragma unroll
                for (int g = 0; g < 4; ++g) { const f32x4 a = *(const LAS f32x4*)(wsf + 8 * g + 4 * hi); av[4 * g] = a.x; av[4 * g + 1] = a.y; av[4 * g + 2] = a.z; av[4 * g + 3] = a.w; }
                o[0] = o[0] * av; o[1] = o[1] * av;
            }
            v4u pw[4];
#pragma unroll
            for (int i = 0; i < 4; ++i) { pw[0][i] = cvt_pk_bf16(p0[2 * i], p0[2 * i + 1]); pw[1][i] = cvt_pk_bf16(p0[8 + 2 * i], p0[9 + 2 * i]); pw[2][i] = cvt_pk_bf16(p1[2 * i], p1[2 * i + 1]); pw[3][i] = cvt_pk_bf16(p1[8 + 2 * i], p1[9 + 2 * i]); }
#pragma unroll
            for (int d0 = 0; d0 < 2; ++d0)
#pragma unroll
                for (int ks = 0; ks < 4; ++ks) {
                    const LAS unsigned char* vp = Vs + vrd0 + d0 * 4096 + ks * 1024;
                    const s16x4 vlo = __builtin_bit_cast(s16x4, __builtin_amdgcn_ds_read_tr16_b64_v4i16((LAS v4i16_t*)vp));
                    const s16x4 vhi = __builtin_bit_cast(s16x4, __builtin_amdgcn_ds_read_tr16_b64_v4i16((LAS v4i16_t*)(vp + 512)));
                    const bf16x8 vf = (bf16x8){vlo[0], vlo[1], vlo[2], vlo[3], vhi[0], vhi[1], vhi[2], vhi[3]};
                    o[d0] = __builtin_amdgcn_mfma_f32_32x32x16_bf16(__builtin_bit_cast(bf16x8, pw[ks]), vf, o[d0], 0, 0, 0);
                }
        }
        if (t + 2 < t_hi) { if (three) asm volatile("s_waitcnt vmcnt(3)" ::: "memory"); else asm volatile("s_waitcnt vmcnt(2)" ::: "memory"); } else VM_WAIT();
        asm volatile("s_waitcnt lgkmcnt(0)" ::: "memory"); __builtin_amdgcn_s_barrier(); asm volatile("" ::: "memory");
        slot = (slot == 2) ? 0 : slot + 1;
    }
#undef AT_ISSUE
    const float ltot = swap32_add(l_run);
    if (hi == 0) wsf[r32] = 1.0f / ltot;
    LDS_WAIT();
    float rli[16];
#pragma unroll
    for (int g = 0; g < 4; ++g) { const f32x4 a = *(const LAS f32x4*)(wsf + 8 * g + 4 * hi); rli[4 * g] = a.x; rli[4 * g + 1] = a.y; rli[4 * g + 2] = a.z; rli[4 * g + 3] = a.w; }
    LAS bf16* stg = (LAS bf16*)(lds + wid * 4096);
#pragma unroll
    for (int r = 0; r < 16; ++r) { const int orow = crow(r, hi);
#pragma unroll
        for (int d0 = 0; d0 < 2; ++d0) stg[orow * 64 + d0 * 32 + r32] = (bf16)f2bf(o[d0][r] * rli[r]); }
    LDS_WAIT();
    bf16* Ow = WSP(bf16, WS_MIXED) + (tokb + 64 * cw + 32 * (wid & 1)) * DM + mixcol;
#pragma unroll
    for (int i = 0; i < 4; ++i) { const int row = i * 8 + (lane >> 3), ch = lane & 7; const v4u v = *(const LAS v4u*)(stg + row * 64 + ch * 8); *(v4u*)(Ow + (size_t)row * DM + ch * 8) = v; }
    LDS_WAIT(); __syncthreads();
}

__device__ __forceinline__ int queue_next(Frame& F, int qi) {
    if (F.tid == 0) F.MISC[16] = __hip_atomic_fetch_add((unsigned*)(F.ctl + CW_Q + 64 * qi), 1u, __ATOMIC_RELAXED, __HIP_MEMORY_SCOPE_AGENT);
    __syncthreads();
    const int v = (int)F.MISC[16];
    __syncthreads();
    return v;
}
#define A6_SBAR() __builtin_amdgcn_sched_barrier(0)
#define A6_PIN(x) asm volatile("" : "+v"(x))
#define A6_WAIT_BAR(N) asm volatile("s_waitcnt vmcnt(" #N ") lgkmcnt(0)\n\ts_barrier" ::: "memory")
#define A6_MFMA(a, b, c) __builtin_amdgcn_mfma_f32_32x32x16_bf16(a, b, c, 0, 0, 0)
typedef const LAS unsigned char* a6_lptr;
__device__ __forceinline__ void a6_glds16(const void* g, unsigned lds_base) {
    unsigned sv; asm volatile("s_mov_b32 %0, m0\n\ts_mov_b32 m0, %2\n\ts_nop 0\n\tglobal_load_lds_dwordx4 %1, off\n\ts_mov_b32 m0, %0" : "=&s"(sv) : "v"(g), "s"(lds_base) : "memory"); }
__device__ __forceinline__ void a6_kload2(bf16x8* kf, a6_lptr kp, int j) { kf[2 * j] = *(const LAS bf16x8*)(kp + j * 2048); kf[2 * j + 1] = *(const LAS bf16x8*)(kp + j * 2048 + 512); }
__device__ __forceinline__ s16x4 a6_vtr(a6_lptr p) { return __builtin_bit_cast(s16x4, __builtin_amdgcn_ds_read_tr16_b64_v4i16((LAS v4i16_t*)p)); }
#define A6_MX3(a, b, c) __builtin_fmaxf(__builtin_fmaxf((a), (b)), (c))
__device__ __forceinline__ float a6_rowmax(const f32x16& p0, const f32x16& p1) {
    float a = A6_MX3(p0[0], p0[1], p1[0]), b = A6_MX3(p0[2], p0[3], p1[1]); a = A6_MX3(a, p1[2], p1[3]);
#pragma unroll
    for (int r = 4; r < 16; r += 4) { a = A6_MX3(a, p0[r], p0[r + 1]); b = A6_MX3(b, p0[r + 2], p0[r + 3]); a = A6_MX3(a, p1[r], p1[r + 1]); b = A6_MX3(b, p1[r + 2], p1[r + 3]); }
    float m = __builtin_fmaxf(a, b);
    auto rr = __builtin_amdgcn_permlane32_swap(__float_as_uint(m), __float_as_uint(m), false, false); const unsigned x_ = rr[0], y_ = rr[1];
    return __builtin_fmaxf(__uint_as_float(x_), __uint_as_float(y_)); }
__device__ __forceinline__ void a6_cmask(f32x16& p0, f32x16& p1, int jb, int qrel, int hi) {
    const int kb = 64 * jb + 4 * hi;
#pragma unroll
    for (int r = 0; r < 16; ++r) { const int kv = kb + (r & 3) + 8 * (r >> 2); if (kv > qrel) p0[r] = -INFINITY; if (kv + 32 > qrel) p1[r] = -INFINITY; } }

template <int KIND>
__device__ __forceinline__ void attn64_unit(Frame& F, const Args& A, int layer, int b, int h, int qb) {
    UNIT_BEGIN();
    constexpr int OFF = (KIND == 1) ? 128 : 256, NTAB = OFF + 64, TPAD = 128, TINF = TPAD + NTAB, SLOTB = 8192;
    constexpr int NKS = (KIND == 2) ? 6 : 4, KSL = (KIND == 2) ? 12288 : 8704;
    constexpr float THR = 8.0f;
    const int tid = F.tid, lane = F.lane, wid = F.wave, r32 = lane & 31, hi = lane >> 5;
    LAS unsigned char* lds = F.lds; const unsigned lds0 = (unsigned)(unsigned long)lds;
    const bf16* proj = WSP(bf16, WS_PROJ);
    const size_t tokb = (size_t)b * SEQ;
    const bf16 *Qg, *Kg, *Vg; int PQ, PK, PV;
    if (KIND == 2) { Qg = WSP(bf16, WS_QMLA) + tokb * 384 + h * 96; Kg = WSP(bf16, WS_KMLA) + tokb * 384 + h * 96; Vg = WSP(bf16, WS_VMLA) + tokb * 256 + h * 64; PQ = 384; PK = 384; PV = 256; }
    else { const int base = (KIND == 0) ? PC_FOX : (KIND == 1) ? PC_DSA : PC_BAND; Qg = proj + tokb * NPROJ + base + h * 64; Kg = Qg + 256; Vg = Qg + 512; PQ = NPROJ; PK = NPROJ; PV = NPROJ; }
    const int mixcol = ((KIND == 0) ? 0 : (KIND == 1) ? 256 : (KIND == 2) ? 512 : 768) + h * 64;
    int t_lo = (KIND == 3) ? ((4 * qb - 8) > 0 ? (4 * qb - 8) : 0) : 0; const int t_hi = 4 * qb + 4;
    const int cw = 4 * qb + (wid >> 1), rsub = 32 * (wid & 1) + r32, qrel = 32 * wid + r32;
    LAS float* tab = (LAS float*)(lds + AT_TAB); LAS float* ctab = (LAS float*)(lds + AT_CUM); LAS float* wsf = (LAS float*)(lds + AT_WS) + wid * 64;
    bf16x8 qr[NKS];
    { const bf16* qp = Qg + (size_t)(64 * cw + rsub) * PQ + 8 * hi;
#pragma unroll
      for (int d0 = 0; d0 < NKS; ++d0) qr[d0] = *(const bf16x8*)(qp + 16 * d0); }
    if (KIND == 0) {
        const float* cu = WSP(float, WS_CUM) + (size_t)(b * 4 + h) * SEQ; const float cref = cu[256 * qb];
        const float* kn = WSP(float, WS_KNORM) + (size_t)(b * 4 + h) * 64;
        { const int n_ = 256 * qb + 256; float cv[4]; const float knv = kn[lane];
#pragma unroll
          for (int i = 0; i < 4; ++i) { const int s_ = tid + 512 * i; cv[i] = cu[s_ < n_ ? s_ : n_ - 1]; }
#pragma unroll
          for (int i = 0; i < 4; ++i) { const int s_ = tid + 512 * i; if (s_ < n_) ctab[s_] = cref - cv[i]; }
          if (wid == 0) tab[16 + lane] = knv; }
        float ss = 0.f;
#pragma unroll
        for (int d0 = 0; d0 < 4; ++d0) { const v4u qw = __builtin_bit_cast(v4u, qr[d0]);
#pragma unroll
            for (int j = 0; j < 4; ++j) { const unsigned w_ = qw[j]; const float lo = __uint_as_float(w_ << 16), hi_ = __uint_as_float(w_ & 0xffff0000u); ss += lo * lo + hi_ * hi_; } }
        ss = wave_max_nn(swap32_add(ss));
        if (lane == 0) tab[wid] = ss;
        __syncthreads();
        float qm = 0.f;
#pragma unroll
        for (int w = 0; w < 8; ++w) qm = fmaxf(qm, tab[w]);
        qm = sqrtf(qm) * 1.002f;
        const float kd = fmaxf(fmaxf(tab[16 + 4 * qb], tab[16 + 4 * qb + 1]), fmaxf(tab[16 + 4 * qb + 2], tab[16 + 4 * qb + 3]));
        const float thr = -(qm * kd) - 40.f;
        int tl = 0; float krun = 0.f;
        while (tl < 4 * qb) { krun = fmaxf(krun, tab[16 + tl]); if (qm * krun + ctab[64 * tl + 63] <= thr) ++tl; else break; }
        t_lo = __builtin_amdgcn_readfirstlane(tl) & ~1;
    }
    const int NT = t_hi - t_lo;
    const int krow_ = 8 * wid + (lane >> 3);
    const bf16* ksrc = (KIND == 2) ? (Kg + (size_t)(64 * t_lo + lane) * PK + wid * 8) : (Kg + (size_t)(64 * t_lo + krow_) * PK + (((lane & 7) ^ (krow_ & 7)) * 8));
    const bf16* ksrc2 = Kg + (size_t)(64 * t_lo + lane) * PK + (8 + (wid & 3)) * 8;
    const bf16* vsrc = Vg + (size_t)(64 * t_lo + 16 * (wid & 3) + (lane >> 2)) * PV + (wid >> 2) * 32 + (lane & 3) * 8;
    const unsigned kdst = lds0 + AT_K + wid * ((KIND == 2) ? 1024 : 1088), kdst2 = lds0 + AT_K + (8 + (wid & 3)) * 1024, vdst = lds0 + AT_V + wid * 1024;
#define DMA_K(t, slot) do { a6_glds16(ksrc + (size_t)(t) * 64 * PK, (unsigned)__builtin_amdgcn_readfirstlane(kdst + (slot))); \
        if (KIND == 2) a6_glds16(ksrc2 + (size_t)(t) * 64 * PK, (unsigned)__builtin_amdgcn_readfirstlane(kdst2 + (slot))); } while (0)
#define DMA_V(t, slot) a6_glds16(vsrc + (size_t)(t) * 64 * PV, (unsigned)__builtin_amdgcn_readfirstlane(vdst + (slot)))
    const a6_lptr kp0 = lds + AT_K + hi * 1024 + r32 * 16;
    int ka[4];
#pragma unroll
    for (int d0 = 0; d0 < 4; ++d0) ka[d0] = AT_K + (r32 >> 3) * 1088 + (r32 & 7) * 128 + (((2 * d0 + hi) ^ (r32 & 7)) * 16);
    const a6_lptr vp0 = lds + AT_V + ((lane >> 4) & 1) * 32 + (lane & 3) * 8 + (4 * hi + ((lane & 15) >> 2)) * 64;
    DMA_K(0, 0); DMA_V(0, 0); DMA_K(1, KSL); DMA_K(2, 2 * KSL);
    if (KIND == 1) {
        const float farc = A.in[7][15 * 4 + h] * LOG2E;
        if (tid < NTAB) { const int rel = tid - OFF, n = rel < 0 ? -rel : rel; int bk; if (n < 8) bk = n; else { bk = 8 + (31 - __clz(n * n)) - 6; bk = bk > 15 ? 15 : bk; } if (rel > 0) bk += 16; tab[TPAD + tid] = A.in[7][bk * 4 + h] * LOG2E; }
        else if (tid < NTAB + TPAD) tab[tid - NTAB] = farc;
        else if (tid < NTAB + TPAD + 64) tab[tid] = -INFINITY;
        if (qb >= 1) { const v2u* gm = WSP(v2u, WS_MASK) + (tokb + 256 * qb) * 32 + tid; LAS v2u* lm = (LAS v2u*)(lds + AT_MASK) + (tid >> 5) * 33 + (tid & 31);
            v2u mv[16];
#pragma unroll
            for (int i = 0; i < 16; ++i) mv[i] = gm[i * 512];
#pragma unroll
            for (int i = 0; i < 16; ++i) lm[i * 16 * 33] = mv[i]; }
    }
    if (KIND == 3) {
        const float* cr = A.in[8] + (size_t)(layer * 4 + h) * 513;
        const float farc = cr[512] * LOG2E;
        if (tid < NTAB) { int d = OFF - tid; d = d < -256 ? -256 : (d > 256 ? 256 : d); tab[TPAD + tid] = cr[d + 256] * LOG2E; }
        else if (tid < NTAB + TPAD) tab[tid - NTAB] = farc;
        else tab[tid] = -INFINITY;
    }
    float mhat = 0.f, l_reg = 0.f; f32x16 o[2]; o[0] = f32x16{}; o[1] = f32x16{};
    bool resc = false;
    f32x16 pA0, pA1, pB0, pB1; bf16x8 kf[2 * NKS]; s16x4 vlo[8], vhi[8]; v4u pw0, pw1, pw2, pw3;
    f32x4 cbA, cbB; unsigned wl = ~0u, wh = ~0u;
    int sl_prev = 0, sl_cur = 0, sl_next = SLOTB, sk_cur = 0, sk_next = KSL; bool visn = true; float nmv = 0.f;
#define ROT() do { sl_prev = sl_cur; sl_cur = sl_next; sl_next = (sl_next == 2 * SLOTB) ? 0 : sl_next + SLOTB; sk_cur = sk_next; sk_next = (sk_next == 2 * KSL) ? 0 : sk_next + KSL; } while (0)
#define WAITB_STEADY() do { if (KIND == 2) { A6_WAIT_BAR(3); } else { A6_WAIT_BAR(2); } } while (0)
    a6_lptr cptr = lds;
#define CSET(tn) do { const int T_ = t_lo + (tn); \
        if (KIND == 0) cptr = (a6_lptr)(ctab + 64 * T_ + 4 * hi); \
        else if (KIND == 2) visn = (T_ <= cw); \
        else { int ix_ = TPAD + 64 * (T_ - cw) - rsub + OFF + 4 * hi; ix_ = ix_ < 0 ? 0 : ix_; \
               const bool vis_ = (KIND == 1) ? (T_ <= cw) : (T_ <= cw && T_ >= cw - 8); ix_ = vis_ ? ix_ : TINF; cptr = (a6_lptr)(tab + ix_); \
               if (KIND == 1) { if (qb >= 1) { const v2u mw_ = ((const LAS v2u*)(lds + AT_MASK))[(64 * (wid >> 1) + rsub) * 33 + T_]; wl = mw_.x >> (4 * hi); wh = mw_.y >> (4 * hi); } } } } while (0)
#define CLD(half, g) ((KIND == 0) ? *(const LAS f32x4*)(cptr + 4 * (32 * (half) + 8 * (g))) \
        : (f32x4){((const LAS float*)cptr)[32 * (half) + 8 * (g)], ((const LAS float*)cptr)[32 * (half) + 8 * (g) + 1], ((const LAS float*)cptr)[32 * (half) + 8 * (g) + 2], ((const LAS float*)cptr)[32 * (half) + 8 * (g) + 3]})
#define CAP1(X, half, g, j, cv) do { float v_ = (KIND == 2) ? nmv : ((cv) - mhat); \
        if (KIND == 1) { const unsigned m_ = (unsigned)__builtin_amdgcn_sbfe((int)((half) ? wh : wl), (j) + 8 * (g), 1); v_ = __uint_as_float(__builtin_amdgcn_bitop3_b32(__float_as_uint(v_), m_, 0xff800000u, 0xE2)); }     \
        X[4 * (g) + (j)] = v_; } while (0)
#define CAP(X, half, g, CB) do { CAP1(X, half, g, 0, CB.x); CAP1(X, half, g, 1, CB.y); CAP1(X, half, g, 2, CB.z); CAP1(X, half, g, 3, CB.w); } while (0)
#define CALL(X0, X1) do { nmv = visn ? -mhat : -INFINITY; _Pragma("unroll") for (int g_ = 0; g_ < 4; ++g_) { f32x4 c0_ = f32x4{}, c1_ = f32x4{}; if (KIND != 2) { c0_ = CLD(0, g_); c1_ = CLD(1, g_); } CAP(X0, 0, g_, c0_); CAP(X1, 1, g_, c1_); } } while (0)
#define RESC() do { if (resc) { LDS_WAIT(); _Pragma("unroll") for (int g_ = 0; g_ < 4; ++g_) { const f32x4 a_ = *(const LAS f32x4*)(wsf + 8 * g_ + 4 * hi); \
        _Pragma("unroll") for (int d_ = 0; d_ < 2; ++d_) { o[d_][4 * g_] *= a_.x; o[d_][4 * g_ + 1] *= a_.y; o[d_][4 * g_ + 2] *= a_.z; o[d_][4 * g_ + 3] *= a_.w; } } } } while (0)
#define DECIDE(C0, C1) do { const float rm_ = a6_rowmax(C0, C1); resc = false; \
        if (__builtin_expect(__any(rm_ > THR), 0)) { const float dl_ = fmaxf(rm_, 0.f); mhat += dl_; \
            _Pragma("unroll") for (int r = 0; r < 16; ++r) { C0[r] -= dl_; C1[r] -= dl_; } \
            const float f_ = __builtin_amdgcn_exp2f(-dl_); l_reg *= f_; if (hi == 0) wsf[r32] = f_; resc = true; } } while (0)
    if (KIND == 2) { A6_WAIT_BAR(5); } else { A6_WAIT_BAR(3); }
    CSET(0); CALL(pA0, pA1);
    _Pragma("unroll") for (int d0 = 0; d0 < NKS; ++d0) { if (KIND == 2) a6_kload2(kf, kp0, d0); else { kf[2 * d0] = *(const LAS bf16x8*)(lds + ka[d0 & 3]); kf[2 * d0 + 1] = *(const LAS bf16x8*)(lds + ka[d0 & 3] + 4352); } }
    _Pragma("unroll") for (int d0 = 0; d0 < NKS; ++d0) { pA0 = A6_MFMA(kf[2 * d0], qr[d0], pA0); pA1 = A6_MFMA(kf[2 * d0 + 1], qr[d0], pA1); }
    if (KIND == 0) { if (NT == 4) a6_cmask(pA0, pA1, 0, qrel, hi); }
    DECIDE(pA0, pA1);
#pragma unroll
    for (int r = 0; r < 16; ++r) { pA0[r] = __builtin_amdgcn_exp2f(pA0[r]); pA1[r] = __builtin_amdgcn_exp2f(pA1[r]); }
    CSET(1); CALL(pB0, pB1);
    A6_WAIT_BAR(0);
    DMA_K(3, 0); DMA_V(1, SLOTB); ROT();
    _Pragma("unroll") for (int d0 = 0; d0 < NKS; ++d0) { if (KIND == 2) a6_kload2(kf, kp0 + sk_cur, d0); else { kf[2 * d0] = *(const LAS bf16x8*)(lds + sk_cur + ka[d0 & 3]); kf[2 * d0 + 1] = *(const LAS bf16x8*)(lds + sk_cur + ka[d0 & 3] + 4352); } }
    WAITB_STEADY();
#define PKW(P, i) cvt_pk_bf16(P[i], P[(i) + 1])
#define PAF(k) __builtin_bit_cast(bf16x8, pw##k)
#define VFR(i) (bf16x8){vlo[i][0], vlo[i][1], vlo[i][2], vlo[i][3], vhi[i][0], vhi[i][1], vhi[i][2], vhi[i][3]}
#define VRD(i) do { vlo[i] = a6_vtr(vp_ + (((i) >> 2) * 4096 + ((i) & 3) * 1024)); vhi[i] = a6_vtr(vp_ + (((i) >> 2) * 4096 + ((i) & 3) * 1024 + 512)); } while (0)
#define KRD(G, j) do { if (G) { if (KIND == 2) a6_kload2(kf, kp0 + sk_next, j); else { kf[2 * (j)] = *(const LAS bf16x8*)(lds + sk_next + ka[(j) & 3]); kf[2 * (j) + 1] = *(const LAS bf16x8*)(lds + sk_next + ka[(j) & 3] + 4352); } A6_SBAR(); } } while (0)
#define GAPA(MF, a0, a1, a2, a3, W0, W1, PW) do { MF; sacc += a0; sacc += a1; sacc += a2; sacc += a3; A6_PIN(sacc); W0; W1; A6_PIN(PW); A6_SBAR(); } while (0)
#define GAPB(MF, X, B, GL, PX, half, g, CUR, NXT, nh, ng, LDN) do { if ((KIND != 2) && (GL) && (LDN)) NXT = CLD(nh, ng); MF; \
        X[B] = __builtin_amdgcn_exp2f(X[B]); X[(B) + 1] = __builtin_amdgcn_exp2f(X[(B) + 1]); X[(B) + 2] = __builtin_amdgcn_exp2f(X[(B) + 2]); X[(B) + 3] = __builtin_amdgcn_exp2f(X[(B) + 3]); A6_PIN(X); \
        if (GL) { CAP(PX, half, g, CUR); A6_PIN(PX); } A6_SBAR(); } while (0)
#define STEP(C0, C1, P0, P1, t, MASK, GK, GV, GL) do { A6_SBAR(); \
    const a6_lptr vp_ = vp0 + sl_prev; \
    VRD(0); A6_SBAR(); float sacc = P0[0] + P0[1]; \
                       GAPA(C0 = A6_MFMA(kf[0], qr[0], C0), P0[2], P0[3], P0[4], P0[5],     pw0[0] = PKW(P0, 0),  pw0[1] = PKW(P0, 2),  pw0); \
    VRD(4); A6_SBAR(); GAPA(C1 = A6_MFMA(kf[1], qr[0], C1), P0[6], P0[7], P0[8], P0[9],     pw0[2] = PKW(P0, 4),  pw0[3] = PKW(P0, 6),  pw0); \
    VRD(1); A6_SBAR(); GAPA(C0 = A6_MFMA(kf[2], qr[1], C0), P0[10], P0[11], P0[12], P0[13], pw1[0] = PKW(P0, 8),  pw1[1] = PKW(P0, 10), pw1); \
    VRD(5); A6_SBAR(); GAPA(C1 = A6_MFMA(kf[3], qr[1], C1), P0[14], P0[15], P1[0], P1[1],   pw1[2] = PKW(P0, 12), pw1[3] = PKW(P0, 14), pw1); \
    VRD(2); A6_SBAR(); GAPA(C0 = A6_MFMA(kf[4], qr[2], C0), P1[2], P1[3], P1[4], P1[5],     pw2[0] = PKW(P1, 0),  pw2[1] = PKW(P1, 2),  pw2); \
    VRD(6); A6_SBAR(); GAPA(C1 = A6_MFMA(kf[5], qr[2], C1), P1[6], P1[7], P1[8], P1[9],     pw2[2] = PKW(P1, 4),  pw2[3] = PKW(P1, 6),  pw2); \
    VRD(3); A6_SBAR(); GAPA(C0 = A6_MFMA(kf[6], qr[3], C0), P1[10], P1[11], P1[12], P1[13], pw3[0] = PKW(P1, 8),  pw3[1] = PKW(P1, 10), pw3); \
    VRD(7); A6_SBAR(); GAPA(C1 = A6_MFMA(kf[7], qr[3], C1), P1[14], P1[15], 0.f, 0.f,       pw3[2] = PKW(P1, 12), pw3[3] = PKW(P1, 14), pw3); \
    if (KIND == 2) { C0 = A6_MFMA(kf[2 * NKS - 4], qr[NKS - 2], C0); C1 = A6_MFMA(kf[2 * NKS - 3], qr[NKS - 2], C1); C0 = A6_MFMA(kf[2 * NKS - 2], qr[NKS - 1], C0); C1 = A6_MFMA(kf[2 * NKS - 1], qr[NKS - 1], C1); A6_SBAR(); } \
    l_reg += sacc; \
    if (GK) DMA_K((t) + 3, sk_cur); if (GV) DMA_V((t) + 1, sl_next); \
    if (GL) { CSET((t) + 1); if (KIND != 2) cbA = CLD(0, 0); } \
    if ((KIND == 0) && (MASK)) { const int jb_ = (t) - (NT - 4); if (jb_ >= 0) a6_cmask(C0, C1, jb_, qrel, hi); } \
    DECIDE(C0, C1); nmv = visn ? -mhat : -INFINITY; \
    A6_SBAR(); \
                GAPB(o[0] = A6_MFMA(PAF(0), VFR(0), o[0]), C0, 0,  GL, P0, 0, 0, cbA, cbB, 0, 1, true); \
                GAPB(o[1] = A6_MFMA(PAF(0), VFR(4), o[1]), C0, 4,  GL, P0, 0, 1, cbB, cbA, 0, 2, true); \
    KRD(GL, 0); GAPB(o[0] = A6_MFMA(PAF(1), VFR(1), o[0]), C0, 8,  GL, P0, 0, 2, cbA, cbB, 0, 3, true); \
    KRD(GL, 1); GAPB(o[1] = A6_MFMA(PAF(1), VFR(5), o[1]), C0, 12, GL, P0, 0, 3, cbB, cbA, 1, 0, true); \
    KRD(GL, 2); GAPB(o[0] = A6_MFMA(PAF(2), VFR(2), o[0]), C1, 0,  GL, P1, 1, 0, cbA, cbB, 1, 1, true); \
    KRD(GL, 3); GAPB(o[1] = A6_MFMA(PAF(2), VFR(6), o[1]), C1, 4,  GL, P1, 1, 1, cbB, cbA, 1, 2, true); \
    if (KIND == 2) KRD(GL, NKS - 2); \
                GAPB(o[0] = A6_MFMA(PAF(3), VFR(3), o[0]), C1, 8,  GL, P1, 1, 2, cbA, cbB, 1, 3, true); \
    if (KIND == 2) KRD(GL, NKS - 1); \
                GAPB(o[1] = A6_MFMA(PAF(3), VFR(7), o[1]), C1, 12, GL, P1, 1, 3, cbB, cbA, 0, 0, false); \
    } while (0)
    int t = 1;
    for (; t + 5 < NT; t += 2) {
        STEP(pB0, pB1, pA0, pA1, t, false, true, true, true);     WAITB_STEADY(); RESC(); ROT();
        STEP(pA0, pA1, pB0, pB1, t + 1, false, true, true, true); WAITB_STEADY(); RESC(); ROT();
    }
#define ENDW(tt) do { if ((tt) + 3 < NT) { WAITB_STEADY(); } else if ((tt) + 2 < NT) { A6_WAIT_BAR(1); } else { A6_WAIT_BAR(0); } } while (0)
    for (; t + 1 < NT; t += 2) {
        STEP(pB0, pB1, pA0, pA1, t, true, (t + 3 < NT), true, true);         ENDW(t);     RESC(); ROT();
        STEP(pA0, pA1, pB0, pB1, t + 1, true, (t + 4 < NT), true, true);     ENDW(t + 1); RESC(); ROT();
    }
    STEP(pB0, pB1, pA0, pA1, NT - 1, true, false, false, false); RESC();
    { float sacc = pB0[0] + pB0[1];
#pragma unroll
      for (int r = 2; r < 16; ++r) sacc += pB0[r];
#pragma unroll
      for (int r = 0; r < 16; ++r) sacc += pB1[r];
      l_reg += sacc;
      pw0 = (v4u){PKW(pB0, 0), PKW(pB0, 2), PKW(pB0, 4), PKW(pB0, 6)}; pw1 = (v4u){PKW(pB0, 8), PKW(pB0, 10), PKW(pB0, 12), PKW(pB0, 14)};
      pw2 = (v4u){PKW(pB1, 0), PKW(pB1, 2), PKW(pB1, 4), PKW(pB1, 6)}; pw3 = (v4u){PKW(pB1, 8), PKW(pB1, 10), PKW(pB1, 12), PKW(pB1, 14)};
      const a6_lptr vp_ = vp0 + sl_cur;
#pragma unroll
      for (int i = 0; i < 8; ++i) VRD(i);
      o[0] = A6_MFMA(PAF(0), VFR(0), o[0]); o[1] = A6_MFMA(PAF(0), VFR(4), o[1]); o[0] = A6_MFMA(PAF(1), VFR(1), o[0]); o[1] = A6_MFMA(PAF(1), VFR(5), o[1]);
      o[0] = A6_MFMA(PAF(2), VFR(2), o[0]); o[1] = A6_MFMA(PAF(2), VFR(6), o[1]); o[0] = A6_MFMA(PAF(3), VFR(3), o[0]); o[1] = A6_MFMA(PAF(3), VFR(7), o[1]); }
#undef DMA_K
#undef DMA_V
#undef ROT
#undef CSET
#undef CLD
#undef CAP1
#undef CAP
#undef CALL
#undef RESC
#undef DECIDE
#undef PKW
#undef PAF
#undef VFR
#undef VRD
#undef KRD
#undef GAPA
#undef GAPB
#undef STEP
#undef ENDW
#undef WAITB_STEADY
    const float ltot = swap32_add(l_reg);
    if (hi == 0) wsf[r32] = 1.0f / ltot;
    LDS_WAIT();
    float rli[16];
#pragma unroll
    for (int g = 0; g < 4; ++g) { const f32x4 a = *(const LAS f32x4*)(wsf + 8 * g + 4 * hi); rli[4 * g] = a.x; rli[4 * g + 1] = a.y; rli[4 * g + 2] = a.z; rli[4 * g + 3] = a.w; }
    LAS bf16* stg = (LAS bf16*)(lds + wid * 4096);
#pragma unroll
    for (int r = 0; r < 16; ++r) { const int orow = crow(r, hi);
#pragma unroll
        for (int d0 = 0; d0 < 2; ++d0) stg[orow * 64 + d0 * 32 + r32] = (bf16)cvt_pk_bf16(o[d0][r] * rli[r], 0.f); }
    LDS_WAIT();
    bf16* Ow = WSP(bf16, WS_MIXED) + (tokb + 64 * cw + 32 * (wid & 1)) * DM + mixcol;
#pragma unroll
    for (int i = 0; i < 4; ++i) { const int row = i * 8 + (lane >> 3), ch = lane & 7; const v4u v = *(const LAS v4u*)(stg + row * 64 + ch * 8); *(v4u*)(Ow + (size_t)row * DM + ch * 8) = v; }
    asm volatile("s_waitcnt lgkmcnt(0)\n\ts_barrier" ::: "memory");
}
__device__ __forceinline__ void unpack8(const v4u w, float* v) { v[0] = bflo(w.x); v[1] = bfhi(w.x); v[2] = bflo(w.y); v[3] = bfhi(w.y); v[4] = bflo(w.z); v[5] = bfhi(w.z); v[6] = bflo(w.w); v[7] = bfhi(w.w); }
__device__ __forceinline__ void ln16(float* v, const float* g, const float* bb) {
    float s = 0.f;
#pragma unroll
    for (int i = 0; i < 16; ++i) s += v[i];
    const float mean = wave_sum(s) * (1.0f / DM); float q = 0.f;
#pragma unroll
    for (int i = 0; i < 16; ++i) { v[i] -= mean; q += v[i] * v[i]; }
    const float rstd = rsqrtf(wave_sum(q) * (1.0f / DM) + LN_EPS);
#pragma unroll
    for (int i = 0; i < 16; ++i) v[i] = v[i] * rstd * g[i] + bb[i];
}
__device__ __forceinline__ void load_gb(const float* gp, const float* bp, int lane, float* g, float* bb) {
#pragma unroll
    for (int hf = 0; hf < 2; ++hf)
#pragma unroll
        for (int q = 0; q < 2; ++q) { const f32x4 a = *(const f32x4*)(gp + 512 * hf + 8 * lane + 4 * q), c = *(const f32x4*)(bp + 512 * hf + 8 * lane + 4 * q);
            g[8 * hf + 4 * q] = a.x; g[8 * hf + 4 * q + 1] = a.y; g[8 * hf + 4 * q + 2] = a.z; g[8 * hf + 4 * q + 3] = a.w;
            bb[8 * hf + 4 * q] = c.x; bb[8 * hf + 4 * q + 1] = c.y; bb[8 * hf + 4 * q + 2] = c.z; bb[8 * hf + 4 * q + 3] = c.w; }
}
__device__ __forceinline__ v4u pack8(const float* v) { v4u w; w.x = cvt_pk_bf16(v[0], v[1]); w.y = cvt_pk_bf16(v[2], v[3]); w.z = cvt_pk_bf16(v[4], v[5]); w.w = cvt_pk_bf16(v[6], v[7]); return w; }

__device__ __forceinline__ void ln1_router_unit(Frame& F, const Args& A, int layer, int unit) {
    UNIT_BEGIN();
    const int lane = F.lane, wid = F.wave, tid = F.tid, r32 = lane & 31, hi = lane >> 5;
    const bool dry = A.rep != 0;
    const bf16* y1 = WSP(bf16, WS_Y1); bf16* xb = dry ? WSP(bf16, WS_MIXED) : WSP(bf16, WS_XB);
    LAS float* lg = (LAS float*)(F.lds);
    LAS int* hist = (LAS int*)(F.lds + 33280);
    LAS int* basee = (LAS int*)(F.lds + 33536);
    LAS int* ek = (LAS int*)(F.lds + 33792);
    LAS float* gk = (LAS float*)(F.lds + 37888);
    const int tok0 = unit * 128;
    {
        float g[16], bb[16]; load_gb(A.in[10] + layer * DM, A.in[11] + layer * DM, lane, g, bb);
        for (int i4 = 0; i4 < 16; i4 += 8) {
            v4u ld[8][2];
#pragma unroll
            for (int q = 0; q < 8; ++q) { const size_t row = (size_t)(tok0 + wid * 16 + i4 + q) * DM; ld[q][0] = __builtin_nontemporal_load((const v4u*)(y1 + row + 8 * lane)); ld[q][1] = __builtin_nontemporal_load((const v4u*)(y1 + row + 512 + 8 * lane)); }
#pragma unroll
            for (int q = 0; q < 8; ++q) { const size_t row = (size_t)(tok0 + wid * 16 + i4 + q) * DM;
                float v[16]; unpack8(ld[q][0], v); unpack8(ld[q][1], v + 8);
                ln16(v, g, bb);
                *(v4u*)(xb + row + 8 * lane) = pack8(v); *(v4u*)(xb + row + 512 + 8 * lane) = pack8(v + 8); }
        }
    }
#ifdef P5_PROBE_CUT
    if (dry && P5_PROBE_CUT <= 1) { VM_WAIT(); __syncthreads(); return; }
#endif
    VM_WAIT(); __syncthreads();
    {
        const int rt = wid & 3, ct = wid >> 2;
        const unsigned lds0 = (unsigned)(unsigned long)F.lds;
        const char* xg = (const char*)xb + (size_t)tok0 * 2048; const char* hg = (const char*)(WSP(bf16, WS_WRH) + (size_t)layer * 64 * 1024); const char* lgw = (const char*)(WSP(bf16, WS_WRL) + (size_t)layer * 64 * 1024);
        const int lrow = lane >> 4, lp = lane & 15;
#define R_ISSUE(c, bo) do { \
            _Pragma("unroll") for (int i_ = 0; i_ < 4; ++i_) { const int q_ = 4 * wid + i_, row_ = 4 * q_ + lrow; \
                a6_glds16(xg + (size_t)row_ * 2048 + (c) * 256 + ((lp ^ (row_ & 15)) * 16), (unsigned)__builtin_amdgcn_readfirstlane(lds0 + (bo) + q_ * 1024)); } \
            _Pragma("unroll") for (int i_ = 0; i_ < 2; ++i_) { const int q_ = 2 * wid + i_, row_ = 4 * q_ + lrow; \
                a6_glds16(hg + (size_t)row_ * 2048 + (c) * 256 + ((lp ^ (row_ & 15)) * 16), (unsigned)__builtin_amdgcn_readfirstlane(lds0 + (bo) + 32768 + q_ * 1024)); \
                a6_glds16(lgw + (size_t)row_ * 2048 + (c) * 256 + ((lp ^ (row_ & 15)) * 16), (unsigned)__builtin_amdgcn_readfirstlane(lds0 + (bo) + 49152 + q_ * 1024)); } } while (0)
        R_ISSUE(0, 0); R_ISSUE(1, 65536);
        f32x16 acc = {};
        const int arow = 32 * rt + r32, brow = 32 * ct + r32;
        for (int c = 0; c < 8; ++c) {
            if (c + 1 < 8) { A6_WAIT_BAR(8); } else { A6_WAIT_BAR(0); }
            const LAS unsigned char* bp = F.lds + (c & 1) * 65536;
#pragma unroll
            for (int s_ = 0; s_ < 8; ++s_) { const int P = 2 * s_ + hi;
                const bf16x8 a = *(const LAS bf16x8*)(bp + arow * 256 + ((P ^ (arow & 15)) * 16));
                const bf16x8 b1 = *(const LAS bf16x8*)(bp + 32768 + brow * 256 + ((P ^ (brow & 15)) * 16)), b2 = *(const LAS bf16x8*)(bp + 49152 + brow * 256 + ((P ^ (brow & 15)) * 16));
                acc = __builtin_amdgcn_mfma_f32_32x32x16_bf16(a, b1, acc, 0, 0, 0); acc = __builtin_amdgcn_mfma_f32_32x32x16_bf16(a, b2, acc, 0, 0, 0); }
            if (c + 2 < 8) { asm volatile("s_waitcnt lgkmcnt(0)\n\ts_barrier" ::: "memory"); R_ISSUE(c + 2, (c & 1) * 65536); }
        }
#undef R_ISSUE
        asm volatile("s_waitcnt lgkmcnt(0)\n\ts_barrier" ::: "memory");
#pragma unroll
        for (int r = 0; r < 16; ++r) lg[(32 * rt + crow(r, hi)) * 65 + 32 * ct + r32] = acc[r];
        if (tid < 64) hist[tid] = 0;
    }
    __syncthreads();
#ifdef P5_PROBE_CUT
    if (dry && P5_PROBE_CUT <= 2) return;
#endif
    {
        const int tk = tid >> 2, sub = tid & 3;
        const float* rb = A.in[13] + layer * 64 + 16 * sub;
        float v[16];
#pragma unroll
        for (int j = 0; j < 16; ++j) { const float z = lg[tk * 65 + 16 * sub + j]; v[j] = __builtin_amdgcn_rcpf(1.0f + __builtin_amdgcn_exp2f(-z * LOG2E)) + rb[j]; }
        unsigned taken = 0u; int se[8]; float ssum = 0.f; float ss[8];
#pragma unroll
        for (int k = 0; k < 8; ++k) {
            float best = -INFINITY; int bi = 0;
#pragma unroll
            for (int j = 0; j < 16; ++j) { const bool ok = !((taken >> j) & 1u) && (v[j] > best); best = ok ? v[j] : best; bi = ok ? j : bi; }
            int gi = 16 * sub + bi;
#pragma unroll
            for (int st = 0; st < 2; ++st) {
                const float ob = __builtin_bit_cast(float, st ? __builtin_amdgcn_update_dpp(0, __builtin_bit_cast(int, best), 0x4E, 0xF, 0xF, true) : __builtin_amdgcn_update_dpp(0, __builtin_bit_cast(int, best), 0xB1, 0xF, 0xF, true));
                const int og = st ? __builtin_amdgcn_update_dpp(0, gi, 0x4E, 0xF, 0xF, true) : __builtin_amdgcn_update_dpp(0, gi, 0xB1, 0xF, 0xF, true);
                const bool take = (ob > best) || (ob == best && og < gi);
                best = take ? ob : best; gi = take ? og : gi;
            }
            if ((gi >> 4) == sub) taken |= 1u << (gi & 15);
            se[k] = gi;
            const float z = lg[tk * 65 + gi]; ss[k] = __builtin_amdgcn_rcpf(1.0f + __builtin_amdgcn_exp2f(-z * LOG2E)); ssum += ss[k];
        }
        const float sc = 2.5f / ssum;
#pragma unroll
        for (int k = 0; k < 8; ++k) if ((k >> 1) == sub) { const int pos = atomicAdd((int*)&hist[se[k]], 1); ek[tk * 8 + k] = se[k] | (pos << 8); gk[tk * 8 + k] = ss[k] * sc; }
    }
    __syncthreads();
#ifdef P5_PROBE_CUT
    if (dry && P5_PROBE_CUT <= 3) return;
#endif
    if (tid < 64) basee[tid] = (int)__hip_atomic_fetch_add((unsigned*)(F.ctl + CW_CNT + 64 * layer + tid + (dry ? 4096 : 0)), (unsigned)hist[tid], __ATOMIC_RELAXED, __HIP_MEMORY_SCOPE_AGENT);
    __syncthreads();
    {
        int* list = dry ? WSP(int, WS_QMLA) : WSP(int, WS_LIST); float* gate = dry ? WSP(float, WS_VMLA) : WSP(float, WS_GATE); unsigned* sref = dry ? WSP(unsigned, WS_KMLA) : WSP(unsigned, WS_SREF);
        for (int i = tid; i < 1024; i += 512) { const int w = ek[i], e = w & 255, pos = w >> 8; const int rid = (tok0 + (i >> 3)) * 8 + (i & 7);
            const int slot = basee[e] + pos; if (slot < NT) list[(size_t)e * NT + slot] = rid; gate[rid] = gk[i]; sref[rid] = ((unsigned)e << 16) | (unsigned)slot; }
    }
    __syncthreads();
}

__device__ __forceinline__ void reduce_ln2_rows(Frame& F, const Args& A, int layer, bool last) {
    const int lane = F.lane; const int gw = F.vcu * 8 + F.wave, NGW = F.G * 8;
    bf16* xb = WSP(bf16, WS_XB); const bf16* yb = WSP(bf16, WS_YBUF); const bool dry = A.rep != 0; bf16* xo = dry ? WSP(bf16, WS_Y1) : xb;
    const unsigned* sref = WSP(unsigned, WS_SREF); const float* gates = WSP(float, WS_GATE);
    LAS unsigned* pre256 = (LAS unsigned*)(F.lds);
    {   unsigned cnt_lane = __hip_atomic_load((const unsigned*)(F.ctl + CW_CNT + 64 * layer) + lane, __ATOMIC_RELAXED, __HIP_MEMORY_SCOPE_AGENT);
        if (cnt_lane > (unsigned)NT) cnt_lane = NT;
        const unsigned nt_ = (cnt_lane + 255u) >> 8; unsigned pre = 0u, tot = 0u;
#pragma unroll
        for (int j = 0; j < 64; ++j) { const unsigned v = (unsigned)__builtin_amdgcn_readlane((int)nt_, j); pre += (j < lane) ? v : 0u; tot += v; }
        pre256[lane] = 256u * pre; if (lane == 0) pre256[64] = 256u * tot;
        __syncthreads();
    }
    const unsigned shbase = pre256[64];
#if YFP8
    float g[16], bb[16]; load_gb(A.in[18] + layer * DM, A.in[19] + layer * DM, lane, g, bb);
    const unsigned char* yb8 = (const unsigned char*)yb;
    for (int m0 = gw; m0 < NT; m0 += 2 * NGW) {
        v4u lx[2][2]; v2u ly[2][9][2]; f32x4 gq[2][2];
#pragma unroll
        for (int q = 0; q < 2; ++q) { const int m = m0 + q * NGW; const size_t row = (size_t)m * DM;
            lx[q][0] = __builtin_nontemporal_load((const v4u*)(xb + row + 8 * lane)); lx[q][1] = __builtin_nontemporal_load((const v4u*)(xb + row + 512 + 8 * lane));
            const v4u s0 = *(const v4u*)(sref + (size_t)m * 8), s1 = *(const v4u*)(sref + (size_t)m * 8 + 4);
            gq[q][0] = *(const f32x4*)(gates + (size_t)m * 8); gq[q][1] = *(const f32x4*)(gates + (size_t)m * 8 + 4);
#pragma unroll
            for (int k = 0; k < 9; ++k) { const unsigned sr = (k < 4) ? s0[k & 3] : s1[k & 3];
                const size_t yr = (k < 8) ? (size_t)(pre256[(sr >> 16) & 63] + (sr & 0xffffu)) * DM : (size_t)(shbase + (unsigned)m) * DM;
                ly[q][k][0] = __builtin_nontemporal_load((const v2u*)(yb8 + yr + 8 * lane)); ly[q][k][1] = __builtin_nontemporal_load((const v2u*)(yb8 + yr + 512 + 8 * lane)); } }
#pragma unroll
        for (int q = 0; q < 2; ++q) { const int m = m0 + q * NGW; const size_t row = (size_t)m * DM;
            float v[16]; unpack8(lx[q][0], v); unpack8(lx[q][1], v + 8);
            float ys[16];
#pragma unroll
            for (int i = 0; i < 16; ++i) ys[i] = 0.f;
#pragma unroll
            for (int k = 0; k < 9; ++k) { const float gk_ = (k < 4) ? gq[q][0][k & 3] : (k < 8) ? gq[q][1][k & 3] : 1.0f;
#pragma unroll
                for (int hf = 0; hf < 2; ++hf)
#pragma unroll
                    for (int d = 0; d < 2; ++d) { const int wd = (int)ly[q][k][hf][d]; const auto lo = __builtin_amdgcn_cvt_pk_f32_fp8(wd, false); const auto hi2 = __builtin_amdgcn_cvt_pk_f32_fp8(wd, true);
                        ys[8 * hf + 4 * d] = fmaf(gk_, lo[0], ys[8 * hf + 4 * d]); ys[8 * hf + 4 * d + 1] = fmaf(gk_, lo[1], ys[8 * hf + 4 * d + 1]);
                        ys[8 * hf + 4 * d + 2] = fmaf(gk_, hi2[0], ys[8 * hf + 4 * d + 2]); ys[8 * hf + 4 * d + 3] = fmaf(gk_, hi2[1], ys[8 * hf + 4 * d + 3]); } }
#pragma unroll
            for (int i = 0; i < 16; ++i) v[i] = v[i] * ALPHA + ys[i] * YINV;
            ln16(v, g, bb);
            if (!last) { *(v4u*)(xo + row + 8 * lane) = pack8(v); *(v4u*)(xo + row + 512 + 8 * lane) = pack8(v + 8); }
            if (last && !dry) { float* op = A.out + row;
                __builtin_nontemporal_store((f32x4){v[0], v[1], v[2], v[3]}, (f32x4*)(op + 8 * lane)); __builtin_nontemporal_store((f32x4){v[4], v[5], v[6], v[7]}, (f32x4*)(op + 8 * lane + 4));
                __builtin_nontemporal_store((f32x4){v[8], v[9], v[10], v[11]}, (f32x4*)(op + 512 + 8 * lane)); __builtin_nontemporal_store((f32x4){v[12], v[13], v[14], v[15]}, (f32x4*)(op + 512 + 8 * lane + 4)); } }
    }
}
#else
    float g[16], bb[16]; load_gb(A.in[18] + layer * DM, A.in[19] + layer * DM, lane, g, bb);
    for (int m0 = gw; m0 < NT; m0 += 2 * NGW) {
        v4u ld[2][20];
#pragma unroll
        for (int q = 0; q < 2; ++q) { const int m = m0 + q * NGW; const size_t row = (size_t)m * DM;
            ld[q][0] = *(const v4u*)(xb + row + 8 * lane); ld[q][1] = *(const v4u*)(xb + row + 512 + 8 * lane);
            const v4u s0 = *(const v4u*)(sref + (size_t)m * 8), s1 = *(const v4u*)(sref + (size_t)m * 8 + 4);
#pragma unroll
            for (int k = 0; k < 9; ++k) { const unsigned sr = (k < 4) ? s0[k & 3] : s1[k & 3];
                const size_t yr = (k < 8) ? (size_t)(pre256[(sr >> 16) & 63] + (sr & 0xffffu)) * DM : (size_t)(shbase + (unsigned)m) * DM;
                ld[q][2 + 2 * k] = *(const v4u*)(yb + yr + 8 * lane); ld[q][3 + 2 * k] = *(const v4u*)(yb + yr + 512 + 8 * lane); } }
#pragma unroll
        for (int q = 0; q < 2; ++q) { const int m = m0 + q * NGW; const size_t row = (size_t)m * DM;
            float v[16]; unpack8(ld[q][0], v); unpack8(ld[q][1], v + 8);
#pragma unroll
            for (int i = 0; i < 16; ++i) v[i] *= ALPHA;
#pragma unroll
            for (int k = 0; k < 9; ++k) { float t[16]; unpack8(ld[q][2 + 2 * k], t); unpack8(ld[q][3 + 2 * k], t + 8);
#pragma unroll
                for (int i = 0; i < 16; ++i) v[i] += t[i]; }
            ln16(v, g, bb);
            *(v4u*)(xo + row + 8 * lane) = pack8(v); *(v4u*)(xo + row + 512 + 8 * lane) = pack8(v + 8);
            if (last && !dry) { float* op = A.out + row;
                *(f32x4*)(op + 8 * lane) = (f32x4){v[0], v[1], v[2], v[3]}; *(f32x4*)(op + 8 * lane + 4) = (f32x4){v[4], v[5], v[6], v[7]};
                *(f32x4*)(op + 512 + 8 * lane) = (f32x4){v[8], v[9], v[10], v[11]}; *(f32x4*)(op + 512 + 8 * lane + 4) = (f32x4){v[12], v[13], v[14], v[15]}; } }
    }
}
#endif
#ifndef MK_MULTI
#define MK_MULTI 0
#endif
constexpr int NPH = 1 + 8 * DEPTH;
#ifndef PHMASK
#define PHMASK 0x1FF
#endif
#define PHON(i) ((PHMASK >> (i)) & 1)
#ifndef P7_PROBE_NOSTORE
#define P7_PROBE_NOSTORE 0
#endif
#ifndef P7_ALIGN
#define P7_ALIGN true
#endif
#ifndef P3REP_SEL
#define P3REP_SEL 15
#endif
#ifndef P2REP_SEL
#define P2REP_SEL 7
#endif

__global__ void __launch_bounds__(512, 2) mk_fwd(Args args) {
    extern __shared__ __attribute__((aligned(16))) unsigned char lds[];
    Frame F;
    F.lds = (LAS unsigned char*)lds; F.MISC = (volatile LAS unsigned*)(F.lds + MISC_OFF);
    F.tid = threadIdx.x; F.lane = F.tid & 63; F.wave = __builtin_amdgcn_readfirstlane(F.tid >> 6); F.wave0 = F.wave;
    F.G = gridDim.x; { const int bx = blockIdx.x; F.vcu = (F.G % 8 == 0) ? (bx % 8) * (F.G / 8) + bx / 8 : bx; }
    F.G0 = F.G; F.vcu0 = F.vcu; F.ws = (GAS unsigned char*)args.ws; F.ws0 = (GAS unsigned char*)args.ws; F.ctl = (gu32*)(args.ws + WS_CTL);
    for (int u = F.tid; u < 64; u += 512) ((LAS unsigned*)(F.lds + MISC_OFF))[u] = 0u;
    __syncthreads();
    const int lo = args.ph_lo, hi = args.ph_hi;
    XcdBarrier bar; bar.bar = (unsigned*)(F.ctl + CW_BAR); bar.x = 0; bar.st = nullptr;
    if (hi - lo > 1) bar = xcd_barrier_post((unsigned*)(F.ctl + CW_BAR), F.MISC + 8, F.tid == 0);
#define IN(k) (lo <= (k) && (k) < hi)
#define BOTH(k) (IN(k) && IN((k) + 1))
#define GRID_BAR() do { const bool ld_ = (F.wave0 == 0) && (lane_id_now() == 0); xcd_barrier(bar, ld_); } while (0)
#define PHASE_BEGIN() do { F.lane = lane_id_now(); F.wave = F.wave0; F.tid = F.wave0 * 64 + F.lane; { GAS unsigned char* w_ = F.ws0; asm volatile("" : "+s"(w_)); F.ws = w_; int g_ = F.G0, v_ = F.vcu0; asm volatile("" : "+s"(g_), "+s"(v_)); F.G = g_; F.vcu = v_; } } while (0)
    LAS int* lists = (LAS int*)(F.lds + LIST_OFF);

    if (PHON(0) && IN(0)) { PHASE_BEGIN(); p0_prologue(F, args); if (BOTH(0)) GRID_BAR(); }

    for (int L = 0; L < DEPTH; ++L) {
        const int pb = 1 + 8 * L;
        if (PHON(1) && IN(pb)) { PHASE_BEGIN();
            pg8::DenseOrder S; S.init(WSP(bf16, WS_WIN) + (size_t)L * NPROJ * 1024, NT, NPROJ, 1024, 1024, F.G, F.vcu);
            pg8::EpiProj E{WSP(bf16, WS_PROJ), WSP(float, WS_AUX), WSP(bf16, WS_IK)};
            pg8::gemm_phase<pg8::EpiProj, pg8::DenseOrder, true>(F.lds, lists, (LAS unsigned*)(F.lds + OFFS_OFF), (const char*)WSP(bf16, WS_XB), 1024, S, E, F.wave0);
            if (BOTH(pb)) GRID_BAR();
        }
        if (PHON(2) && IN(pb + 1)) { PHASE_BEGIN();
            const int nround = (F.G == 256) ? 9 : (1792 + 256 + 64 + F.G - 1) / F.G;
            TkPre tkpre; tkpre.a0 = bf16x8{}; tkpre.wq = f32x4{};
            for (int r = 0; r < nround; ++r) {
                const int u = (F.G == 256) ? (r * 256 + ((r & 1) ? 255 - F.vcu : F.vcu)) : (r * F.G + F.vcu);
                const int p2sel_ = args.rep ? P2REP_SEL : 7;
                if (p2sel_ & 1) if (u < 1792) {
                    int c, b, quarter, cn = -1; bool stage = true, havepre = false;
                    if (F.G == 256) { const int j = F.vcu >> 4, a = j >> 2; b = F.vcu & 15; quarter = j & 3; c = 31 - 4 * r - ((r & 1) ? 3 - a : a); stage = (r == 0); havepre = (r > 0);
                                      if (r < 6) cn = 31 - 4 * (r + 1) - (((r + 1) & 1) ? 3 - a : a); }
                    else { c = 31 - (u >> 6); const int rem = u & 63; b = rem >> 2; quarter = rem & 3; }
                    if (c < 8) topk_unit<16>(F, b, c, quarter, stage, havepre, cn, tkpre);
                    else if (c < 12) topk_unit<24>(F, b, c, quarter, stage, havepre, cn, tkpre);
                    else if (c < 16) topk_unit<32>(F, b, c, quarter, stage, havepre, cn, tkpre);
                    else if (c < 20) topk_unit<40>(F, b, c, quarter, stage, havepre, cn, tkpre);
                    else if (c < 24) topk_unit<48>(F, b, c, quarter, stage, havepre, cn, tkpre);
                    else if (c < 28) topk_unit<56>(F, b, c, quarter, stage, havepre, cn, tkpre);
                    else topk_unit<64>(F, b, c, quarter, stage, havepre, cn, tkpre);
                    if (F.G != 256 || r == 6) __syncthreads();
                }
                if (p2sel_ & 2) if (u >= 1792 && u < 1792 + 256) mla_unit(F, args, L, u - 1792);
                if (p2sel_ & 4) if (u >= 1792 + 256 && u < 1792 + 256 + 64) cum_unit(F, args, L, u - 1792 - 256);
                if (p2sel_ & 4) if (r == nround - 1) knorm_jobs(F);
            }
            if (BOTH(pb + 1)) GRID_BAR();
        }
        if (PHON(3) && IN(pb + 2)) { PHASE_BEGIN();
            for (int uu = F.vcu; uu < 256; uu += F.G) {
                const int bh = uu >> 2, qa = uu & 3; const int p3sel_ = args.rep ? P3REP_SEL : 15;
#pragma unroll
                for (int half = 0; half < 2; ++half) if (p3sel_ & 1) attn64_unit<2>(F, args, L, bh >> 2, bh & 3, half ? qa : 7 - qa);
#pragma unroll
                for (int half = 0; half < 2; ++half) if (p3sel_ & 2) attn64_unit<1>(F, args, L, bh >> 2, bh & 3, half ? qa : 7 - qa);
#pragma unroll
                for (int half = 0; half < 2; ++half) if (p3sel_ & 8) attn64_unit<3>(F, args, L, bh >> 2, bh & 3, half ? qa : 7 - qa);
            }
            for (;;) { const int u = queue_next(F, L); if (u >= 512) break; attn64_unit<0>(F, args, L, (u & 63) >> 2, u & 3, 7 - (u >> 6)); }
            if (BOTH(pb + 2)) GRID_BAR();
        }
        if (PHON(4) && IN(pb + 3)) { PHASE_BEGIN();
            pg8::DenseOrder S; S.init(WSP(bf16, WS_WOUT) + (size_t)L * 1024 * 1024, NT, 1024, 1024, 1024, F.G, F.vcu);
            pg8::EpiOut E{WSP(bf16, WS_XB), WSP(bf16, WS_Y1)};
            pg8::gemm_phase<pg8::EpiOut, pg8::DenseOrder, true>(F.lds, lists, (LAS unsigned*)(F.lds + OFFS_OFF), (const char*)WSP(bf16, WS_MIXED), 1024, S, E, F.wave0);
            if (BOTH(pb + 3)) GRID_BAR();
        }
        if (PHON(5) && IN(pb + 4)) { PHASE_BEGIN();
            for (int u = F.vcu; u < NT / 128; u += F.G) ln1_router_unit(F, args, L, u);
            if (BOTH(pb + 4)) GRID_BAR();
        }
        if (PHON(6) && IN(pb + 5)) { PHASE_BEGIN();
            pg8::GroupedOrder<0> S; S.init(WSP(bf16, WS_WGU) + (size_t)L * 65 * 512 * 1024, WSP(int, WS_LIST), (const unsigned*)(F.ctl + CW_CNT + 64 * L), 512, 1024, 1024, F.G, F.vcu, F.lane, (LAS unsigned*)(F.lds + GRP_OFF));
            pg8::EpiGU<0> E{S, WSP(bf16, WS_ABUF), WSP(float, WS_GATE)};
            pg8::gemm_phase<pg8::EpiGU<0>, pg8::GroupedOrder<0>, true>(F.lds, lists, (LAS unsigned*)(F.lds + OFFS_OFF), (const char*)WSP(bf16, WS_XB), 1024, S, E, F.wave0);
            if (BOTH(pb + 5)) GRID_BAR();
        }
        if (PHON(7) && IN(pb + 6)) { PHASE_BEGIN();
            pg8::GroupedOrder<1> S; S.init(WSP(bf16, WS_WDN) + (size_t)L * 65 * 1024 * 256, WSP(int, WS_LIST), (const unsigned*)(F.ctl + CW_CNT + 64 * L), 1024, 256, 256, F.G, F.vcu, F.lane, (LAS unsigned*)(F.lds + GRP_OFF));
            pg8::EpiDown<1> E{S, WSP(bf16, WS_YBUF), (P7_PROBE_NOSTORE && args.rep) ? 1 : 0};
            pg8::gemm_phase<pg8::EpiDown<1>, pg8::GroupedOrder<1>, P7_ALIGN>(F.lds, lists, (LAS unsigned*)(F.lds + OFFS_OFF), (const char*)WSP(bf16, WS_ABUF), 256, S, E, F.wave0);
            if (BOTH(pb + 6)) GRID_BAR();
        }
        if (PHON(8) && IN(pb + 7)) { PHASE_BEGIN();
            reduce_ln2_rows(F, args, L, L == DEPTH - 1);
            if (BOTH(pb + 7)) GRID_BAR();
        }
    }
#undef IN
#undef BOTH
#undef GRID_BAR
}

#ifdef DBG_STOP
struct DbgBuf { const unsigned short* p; unsigned long long n; };
struct DbgArgs { DbgBuf b[6]; int nb; int pad; };
__global__ void dbg_copy(DbgArgs d, float* out, int nout) {
    for (long long i = blockIdx.x * (long long)blockDim.x + threadIdx.x; i < nout; i += (long long)gridDim.x * blockDim.x) {
        float acc = 0.f;
        for (int b = 0; b < d.nb; ++b) { const unsigned long long stride = (d.b[b].n + (unsigned long long)nout - 1) / (unsigned long long)nout; const unsigned long long j = (unsigned long long)i * stride; if (j < d.b[b].n) acc += (float)d.b[b].p[j]; }
        out[i] = acc;
    }
}
#endif
extern "C" void kernel_launch(void* const* d_in, const int* in_sizes, int n_in, void* d_out, int out_size, void* d_ws, size_t ws_size, hipStream_t stream) {
    static int grid = 0;
    if (grid == 0) {
        if (n_in != 20 || out_size != NT * DM || ws_size < WS_END) { fprintf(stderr, "kernel_launch: unexpected shapes (n_in %d out %d ws %zu)\n", n_in, out_size, ws_size); grid = -1; return; }
        int dev = 0, cus = 0, per_cu = 0;
        if (hipGetDevice(&dev) != hipSuccess || hipDeviceGetAttribute(&cus, hipDeviceAttributeMultiprocessorCount, dev) != hipSuccess) { grid = -1; return; }
        if (hipFuncSetAttribute((const void*)mk_fwd, hipFuncAttributeMaxDynamicSharedMemorySize, LDS_BYTES) != hipSuccess) { fprintf(stderr, "kernel_launch: hipFuncSetAttribute failed\n"); grid = -1; return; }
        if (hipOccupancyMaxActiveBlocksPerMultiprocessor(&per_cu, (const void*)mk_fwd, 512, LDS_BYTES) != hipSuccess || per_cu < 1) fprintf(stderr, "kernel_launch: occupancy query reports %d\n", per_cu);
        (void)hipGetLastError();
        grid = cus;
    }
    if (grid < 0) return;
    (void)hipMemsetAsync((char*)d_ws + WS_CTL, 0, CTL_ZERO_BYTES, stream);
    Args a{};
    for (int i = 0; i < 20; ++i) a.in[i] = (const float*)d_in[i];
    a.out = (float*)d_out; a.ws = (unsigned char*)d_ws;
#ifdef DBG_STOP
    for (int p = 0; p <= DBG_STOP; ++p) { a.ph_lo = p; a.ph_hi = p + 1; hipLaunchKernelGGL(mk_fwd, dim3(grid), dim3(512), LDS_BYTES, stream, a); }
    { DbgArgs d{}; const unsigned char* w = (const unsigned char*)d_ws; int nb = 0;
#define DB(off, bytes) d.b[nb].p = (const unsigned short*)(w + (off)); d.b[nb].n = (unsigned long long)(bytes) / 2; ++nb;
      DBG_BUFS
#undef DB
      d.nb = nb; hipLaunchKernelGGL(dbg_copy, dim3(2048), dim3(256), 0, stream, d, (float*)d_out, out_size); }
#elif MK_MULTI
#ifdef REPEAT_PHASE
    for (int p = 0; p < NPH; ++p) { a.ph_lo = p; a.ph_hi = p + 1; a.rep = 0; hipLaunchKernelGGL(mk_fwd, dim3(grid), dim3(512), LDS_BYTES, stream, a);
        if ((p >= 1 && ((p - 1) % 8) + 1 == REPEAT_PHASE) || (p == 0 && REPEAT_PHASE == 0)) { a.rep = 1; hipLaunchKernelGGL(mk_fwd, dim3(grid), dim3(512), LDS_BYTES, stream, a); } }
#else
    for (int p = 0; p < NPH; ++p) { a.ph_lo = p; a.ph_hi = p + 1; hipLaunchKernelGGL(mk_fwd, dim3(grid), dim3(512), LDS_BYTES, stream, a); }
#endif
#else
    a.ph_lo = 0; a.ph_hi = NPH;
    hipLaunchKernelGGL(mk_fwd, dim3(grid), dim3(512), LDS_BYTES, stream, a);
#endif
    (void)in_sizes;
}
```
